# Optimizing an MI355X kernel written in HIP

```python
import jax, jax.numpy as jnp
from jax import lax
import numpy as np

D_MODEL = 1024
BATCH = 16
SEQ = 2048
DEPTH = 1

GRID_W = 64
CTX_LEN = 256
EPS = 1e-6
N_FOURIER_GROUPS = 4
FOURIER_GROUP_DIM = 128
D_FOURIER = N_FOURIER_GROUPS * FOURIER_GROUP_DIM
N_LRU_HEADS = 8
LRU_HEAD_DIM = 64
D_LRU = N_LRU_HEADS * LRU_HEAD_DIM
CONV_WIDTH = 4
CONV_LEFT = 2
LRU_C = 8.0
D_IN = D_FOURIER + 2 * D_LRU + 2 * D_MODEL
N_GROUPS = 4
EXPERTS_PER_GROUP = 8
N_EXPERTS = N_GROUPS * EXPERTS_PER_GROUP
TOP_K = 2
D_EXPERT = 512
MOE_BLOCK = 128

kernel_name = "hybrid_fnet_rglru_hmoe_dit"


def rmsnorm(x, g):
    xf = x.astype(jnp.float32)
    y = xf * lax.rsqrt(jnp.mean(xf * xf, axis=-1, keepdims=True) + EPS)
    return (y * g.astype(jnp.float32)).astype(x.dtype)


def modulate(x, shift, scale):
    return x * (1 + scale) + shift


def fourier_mix(u, grid_w):
    b_, l_, _ = u.shape
    uf = u.astype(jnp.float32)
    if grid_w is not None:
        rows = l_ // grid_w
        uf = uf.reshape(b_, rows, grid_w, N_FOURIER_GROUPS, FOURIER_GROUP_DIM)
        out = jnp.real(jnp.fft.fftn(uf, axes=(1, 2, 4), norm="ortho"))
    else:
        uf = uf.reshape(b_, l_, N_FOURIER_GROUPS, FOURIER_GROUP_DIM)
        out = jnp.real(jnp.fft.fftn(uf, axes=(1, 3), norm="ortho"))
    return out.reshape(b_, l_, D_FOURIER).astype(u.dtype)


def short_conv(u, w, b):
    l_ = u.shape[1]
    up = jnp.pad(u, ((0, 0), (CONV_LEFT, CONV_WIDTH - 1 - CONV_LEFT), (0, 0)))
    return sum(up[:, k:k + l_] * w[k] for k in range(CONV_WIDTH)) + b


def lru_coeffs(xc, w_a, b_a, w_x, b_x, lam):
    b_, l_, _ = xc.shape
    xh = xc.reshape(b_, l_, N_LRU_HEADS, LRU_HEAD_DIM)
    r = jax.nn.sigmoid(jnp.einsum('blhi,hij->blhj', xh, w_a).reshape(b_, l_, D_LRU) + b_a)
    i = jax.nn.sigmoid(jnp.einsum('blhi,hij->blhj', xh, w_x).reshape(b_, l_, D_LRU) + b_x)
    log_a = -LRU_C * r.astype(jnp.float32) * jax.nn.softplus(-lam.astype(jnp.float32))
    a = jnp.exp(log_a)
    mult = jnp.sqrt(-jnp.expm1(2.0 * log_a))
    return a, mult * (i * xc).astype(jnp.float32)


def linear_scan(a, b, h0, reverse):
    if reverse:
        a, b = jnp.flip(a, 1), jnp.flip(b, 1)
    b = b.at[:, 0].add(a[:, 0] * h0)

    def combine(l, r):
        return (l[0] * r[0], r[0] * l[1] + r[1])

    _, h = lax.associative_scan(combine, (a, b), axis=1)
    return jnp.flip(h, 1) if reverse else h


def bidir_rglru(u, conv_w, conv_b, w_a, b_a, w_x, b_x, lam, h0):
    xc = short_conv(u, conv_w, conv_b)
    a_f, b_f = lru_coeffs(xc, w_a[0], b_a[0], w_x[0], b_x[0], lam[0])
    a_b, b_b = lru_coeffs(xc, w_a[1], b_a[1], w_x[1], b_x[1], lam[1])
    return linear_scan(a_f, b_f, h0[0], False), linear_scan(a_b, b_b, h0[1], True)


def token_mixer(h, w_in, conv_w, conv_b, w_a, b_a, w_x, b_x, lam, w_fo, w_lo, w_out, h0, grid_w):
    proj = h @ w_in
    u_f = proj[..., :D_FOURIER]
    u_r = proj[..., D_FOURIER:D_FOURIER + D_LRU]
    y_r = proj[..., D_FOURIER + D_LRU:D_FOURIER + 2 * D_LRU]
    gate_f, gate_r = jnp.split(jax.nn.sigmoid(proj[..., D_FOURIER + 2 * D_LRU:]), 2, axis=-1)
    branch_f = fourier_mix(u_f, grid_w) @ w_fo
    h_f, h_b = bidir_rglru(u_r, conv_w, conv_b, w_a, b_a, w_x, b_x, lam, h0)
    branch_r = ((h_f + h_b) * jax.nn.gelu(y_r.astype(jnp.float32))).astype(h.dtype) @ w_lo
    return (gate_f * branch_f + gate_r * branch_r) @ w_out, h_f, h_b


def hier_moe(h, w_group, b_group, w_er, b_er, w_g, w_u, w_d):
    b_, l_, d_ = h.shape
    t = h.reshape(-1, d_)
    n = t.shape[0]
    tf = t.astype(jnp.float32)
    g_logits = tf @ w_group.astype(jnp.float32) + b_group.astype(jnp.float32)
    g_prob = jax.nn.softmax(g_logits, axis=-1)
    grp = jnp.argmax(g_logits, axis=-1)
    p_grp = jnp.take_along_axis(g_prob, grp[:, None], axis=1)[:, 0]
    e_logits = (tf @ w_er.astype(jnp.float32) + b_er.astype(jnp.float32)).reshape(n, N_GROUPS, EXPERTS_PER_GROUP)
    e_sel = jnp.take_along_axis(e_logits, grp[:, None, None], axis=1)[:, 0]
    top_l, top_i = lax.top_k(e_sel, TOP_K)
    w = p_grp[:, None] * jax.nn.softmax(top_l, axis=-1)
    eid = grp[:, None] * EXPERTS_PER_GROUP + top_i

    flat_e = eid.reshape(-1)
    flat_w = w.reshape(-1)
    n_assign = n * TOP_K
    order = jnp.argsort(flat_e)
    se = flat_e[order]
    stok = (order // TOP_K).astype(jnp.int32)
    sw = flat_w[order]
    counts = jnp.bincount(flat_e, length=N_EXPERTS)
    padded = (counts + MOE_BLOCK - 1) // MOE_BLOCK * MOE_BLOCK
    start = jnp.cumsum(counts) - counts
    pend = jnp.cumsum(padded)
    pstart = pend - padded
    pos = pstart[se] + jnp.arange(n_assign) - start[se]
    n_rows = n_assign + N_EXPERTS * MOE_BLOCK
    n_blk = n_rows // MOE_BLOCK
    row_tok = jnp.full((n_rows,), n, jnp.int32).at[pos].set(stok)
    row_w = jnp.zeros((n_rows,), jnp.float32).at[pos].set(sw)
    blk_e = jnp.minimum(jnp.searchsorted(pend, jnp.arange(n_blk) * MOE_BLOCK, side='right'), N_EXPERTS - 1)
    t_pad = jnp.concatenate([t, jnp.zeros((1, d_), t.dtype)], axis=0)
    xs = t_pad[row_tok].reshape(n_blk, MOE_BLOCK, d_)

    def expert_block(args):
        xb, e = args
        hb = jax.nn.silu(xb @ w_g[e]) * (xb @ w_u[e])
        return hb @ w_d[e]

    ys = lax.map(expert_block, (xs, blk_e)).reshape(n_rows, d_)
    out = jnp.zeros((n + 1, d_), jnp.float32).at[row_tok].add(ys.astype(jnp.float32) * row_w[:, None])[:n]
    return out.reshape(b_, l_, d_).astype(h.dtype)


def setup_inputs(seed: int = 0) -> dict:
    key = jax.random.key(seed)
    ks = jax.random.split(key, 28)

    def nrm(k, shape, scale):
        return jax.random.normal(k, shape, jnp.float32) * scale

    s_d = D_MODEL ** -0.5
    a0 = jax.random.uniform(ks[14], (DEPTH, 2, D_LRU), jnp.float32, 0.9, 0.999)
    s = a0 ** (1.0 / LRU_C)
    lam = jnp.log(s) - jnp.log1p(-s)
    return {
        "x": nrm(ks[0], (BATCH, SEQ, D_MODEL), 1.0),
        "c": nrm(ks[1], (BATCH, D_MODEL), 1.0),
        "ctx": nrm(ks[2], (BATCH, CTX_LEN, D_MODEL), 1.0),
        "c_ctx": nrm(ks[3], (D_MODEL,), 1.0),
        "w_mod": nrm(ks[4], (DEPTH, D_MODEL, 6 * D_MODEL), 0.5 * s_d),
        "b_mod": nrm(ks[5], (DEPTH, 6 * D_MODEL), 0.01),
        "norm1_g": 1.0 + nrm(ks[6], (DEPTH, D_MODEL), 0.01),
        "w_in": nrm(ks[7], (DEPTH, D_MODEL, D_IN), s_d),
        "conv_w": nrm(ks[8], (DEPTH, CONV_WIDTH, D_LRU), CONV_WIDTH ** -0.5),
        "conv_b": nrm(ks[9], (DEPTH, D_LRU), 0.01),
        "lru_wa": nrm(ks[10], (DEPTH, 2, N_LRU_HEADS, LRU_HEAD_DIM, LRU_HEAD_DIM), LRU_HEAD_DIM ** -0.5),
        "lru_ba": nrm(ks[11], (DEPTH, 2, D_LRU), 0.01),
        "lru_wx": nrm(ks[12], (DEPTH, 2, N_LRU_HEADS, LRU_HEAD_DIM, LRU_HEAD_DIM), LRU_HEAD_DIM ** -0.5),
        "lru_bx": nrm(ks[13], (DEPTH, 2, D_LRU), 0.01),
        "lru_lam": lam,
        "w_fourier_out": nrm(ks[15], (DEPTH, D_FOURIER, D_MODEL), D_FOURIER ** -0.5),
        "w_lru_out": nrm(ks[16], (DEPTH, D_LRU, D_MODEL), D_LRU ** -0.5),
        "w_out": nrm(ks[17], (DEPTH, D_MODEL, D_MODEL), s_d),
        "norm2_g": 1.0 + nrm(ks[18], (DEPTH, D_MODEL), 0.01),
        "w_group": nrm(ks[19], (DEPTH, D_MODEL, N_GROUPS), s_d),
        "b_group": nrm(ks[20], (DEPTH, N_GROUPS), 0.01),
        "w_expert_router": nrm(ks[21], (DEPTH, D_MODEL, N_EXPERTS), s_d),
        "b_expert_router": nrm(ks[22], (DEPTH, N_EXPERTS), 0.01),
        "w_gate_e": nrm(ks[23], (DEPTH, N_EXPERTS, D_MODEL, D_EXPERT), s_d),
        "w_up_e": nrm(ks[24], (DEPTH, N_EXPERTS, D_MODEL, D_EXPERT), s_d),
        "w_down_e": nrm(ks[25], (DEPTH, N_EXPERTS, D_EXPERT, D_MODEL), D_EXPERT ** -0.5),
        "final_g": 1.0 + nrm(ks[26], (D_MODEL,), 0.01),
    }


def reference(x, c, ctx, c_ctx, w_mod, b_mod, norm1_g, w_in, conv_w, conv_b, lru_wa, lru_ba, lru_wx, lru_bx,
              lru_lam, w_fourier_out, w_lru_out, w_out, norm2_g, w_group, b_group, w_expert_router,
              b_expert_router, w_gate_e, w_up_e, w_down_e, final_g):
    for l in range(DEPTH):
        mod = (jax.nn.silu(c) @ w_mod[l] + b_mod[l])[:, None, :]
        sh1, sc1, g1, sh2, sc2, g2 = jnp.split(mod, 6, axis=-1)
        modc = jax.nn.silu(c_ctx) @ w_mod[l] + b_mod[l]
        csh1, csc1, cg1, csh2, csc2, cg2 = jnp.split(modc, 6, axis=-1)
        lru_p = (conv_w[l], conv_b[l], lru_wa[l], lru_ba[l], lru_wx[l], lru_bx[l], lru_lam[l])
        zeros_h = jnp.zeros((2, ctx.shape[0], D_LRU), jnp.float32)

        hc = modulate(rmsnorm(ctx, norm1_g[l]), csh1, csc1)
        if l < DEPTH - 1:
            mix_c, hcf, hcb = token_mixer(hc, w_in[l], *lru_p, w_fourier_out[l], w_lru_out[l], w_out[l],
                                          zeros_h, None)
        else:
            uc = hc @ w_in[l][:, D_FOURIER:D_FOURIER + D_LRU]
            hcf, hcb = bidir_rglru(uc, *lru_p, zeros_h)
        h0 = jnp.stack([hcf[:, -1], hcb[:, 0]])

        hx = modulate(rmsnorm(x, norm1_g[l]), sh1, sc1)
        mix_x, _, _ = token_mixer(hx, w_in[l], *lru_p, w_fourier_out[l], w_lru_out[l], w_out[l], h0, GRID_W)
        x = x + g1 * mix_x

        moe_p = (w_group[l], b_group[l], w_expert_router[l], b_expert_router[l], w_gate_e[l], w_up_e[l],
                 w_down_e[l])
        x = x + g2 * hier_moe(modulate(rmsnorm(x, norm2_g[l]), sh2, sc2), *moe_p)

        if l < DEPTH - 1:
            ctx = ctx + cg1 * mix_c
            ctx = ctx + cg2 * hier_moe(modulate(rmsnorm(ctx, norm2_g[l]), csh2, csc2), *moe_p)
    return rmsnorm(x, final_g)
```

```cpp
#include <hip/hip_runtime.h>
#include <cstdio>
#include <cstdint>

constexpr int D = 1024, NB = 16, SEQ = 2048, CTX = 256;
constexpr int NT = NB * SEQ;
constexpr int NC = NB * CTX;
constexpr int NTC = NT + NC;
constexpr int DIN = 3584;
constexpr int NE = 32, DE = 512;
constexpr float EPS = 1e-6f;
constexpr int NWAVES = 8;
constexpr int SLOT_ROWS = 65536 + 8192;
constexpr int LIST_CAP = 32768;

constexpr size_t MiB = 1u << 20;
constexpr size_t WS_CTL = 0, CTL_ZERO_BYTES = 1 * MiB;
constexpr size_t WS_MOD = 1 * MiB;
constexpr size_t WS_TOKINFO = 2 * MiB;
constexpr size_t WS_LISTS = 4 * MiB;
constexpr size_t WS_LRUSUM = 8 * MiB;
constexpr size_t WS_WIN = 16 * MiB;
constexpr size_t WS_WFO = 23 * MiB;
constexpr size_t WS_WLO = 24 * MiB;
constexpr size_t WS_WOUT = 25 * MiB;
constexpr size_t WS_WLRU = 27 * MiB;
constexpr size_t WS_WGU = 28 * MiB;
constexpr size_t WS_WD = 92 * MiB;
constexpr size_t WS_HX = 124 * MiB;
constexpr size_t WS_UF = 196 * MiB;
constexpr size_t WS_UR = 228 * MiB;
constexpr size_t WS_GY = 264 * MiB;
constexpr size_t WS_P1 = 228 * MiB;
constexpr size_t WS_GF = 296 * MiB;
constexpr size_t WS_GR = 360 * MiB;
constexpr size_t WS_R = 424 * MiB;
constexpr size_t WS_T = 196 * MiB;
constexpr size_t WS_H = 260 * MiB;
constexpr size_t WS_Y = 332 * MiB;
constexpr size_t WS_END = 512 * MiB;
constexpr int CW_TMO = 0, CW_CODE = 1;
constexpr int CW_CNT = 64;
constexpr int CW_BAR = 4096;

constexpr int LDS_BYTES = 155648;
constexpr int RING_BYTES = 131072;
constexpr int MISC_OFF = 155648 - 1024;

#define GAS __attribute__((address_space(1)))
#define LAS __attribute__((address_space(3)))
typedef unsigned short bf16;
typedef unsigned v4u __attribute__((ext_vector_type(4)));
typedef unsigned v2u __attribute__((ext_vector_type(2)));
typedef float f32x4 __attribute__((ext_vector_type(4)));
typedef float f32x2 __attribute__((ext_vector_type(2)));
typedef short bf16x8 __attribute__((ext_vector_type(8)));
typedef GAS unsigned gu32;
#define RLX_AGENT __ATOMIC_RELAXED, __HIP_MEMORY_SCOPE_AGENT
#define LDS_WAIT() asm volatile("s_waitcnt lgkmcnt(0)" ::: "memory")
#define VM_WAIT() asm volatile("s_waitcnt vmcnt(0)" ::: "memory")
__device__ __forceinline__ unsigned f2bf(float f) { unsigned u = __builtin_bit_cast(unsigned, f); return (u + 0x7fffu + ((u >> 16) & 1u)) >> 16; }
typedef __bf16 bf16x2_t __attribute__((ext_vector_type(2)));
__device__ __forceinline__ unsigned pk2(float lo, float hi) { const f32x2 v = {lo, hi}; return __builtin_bit_cast(unsigned, __builtin_convertvector(v, bf16x2_t)); }
__device__ __forceinline__ float bf2f(unsigned b) { return __builtin_bit_cast(float, b << 16); }
__device__ __forceinline__ float fast_sigmoid(float v) { return __builtin_amdgcn_rcpf(1.f + __builtin_amdgcn_exp2f(-1.4426950409f * v)); }
__device__ __forceinline__ float fast_gelu_tanh(float v) { const float u = 1.5957691216f * (v + 0.044715f * v * v * v); return v * fast_sigmoid(u); }
__device__ __forceinline__ float fast_silu(float v) { return v * fast_sigmoid(v); }
__device__ __forceinline__ float wave_sum(float v) {
#pragma unroll
    for (int o = 1; o < 64; o <<= 1) v += __shfl_xor(v, o);
    return v;
}
namespace pg8 {
#define PG8_LAS __attribute__((address_space(3)))
typedef unsigned short bf16_t;
typedef unsigned u32x4 __attribute__((ext_vector_type(4)));
constexpr int BM = 256, BK = 64, HALF = 128, HTB = HALF * BK * 2  , STAGE_BYTES = 8 * HTB, NXCD = 8, WGM = 8;

__host__ __device__ __forceinline__ int lds_byte(int r, int c) { const int st = (r >> 4) * 2 + (c >> 5), rr = r & 15, cc = c & 31, ob = rr * 64 + cc * 2; return st * 1024 + (ob ^ (((ob >> 9) & 1) << 5)); }
__host__ __device__ __forceinline__ void stage_rc(int b, int& R, int& C) { const int st = b / 1024, sb = b % 1024, swz = sb ^ (((sb >> 9) & 1) << 5); R = (st >> 1) * 16 + swz / 64; C = (st & 1) * 32 + (swz % 64) / 2; }
__host__ __device__ __forceinline__ int perm32(int rho) { const int n = rho >> 4, i = rho & 15; return 8 * (i >> 2) + 4 * n + (i & 3); }

struct Unit { int pm, pn; const char* a; const char* b; const int* rows; int nrows; int aux; };

__host__ __device__ __forceinline__ void static_tile(int L, int nM, int nN, int& pm, int& pn) {
    const int nwg = nM * nN; int wgid = L; { const int q = nwg / NXCD, r = nwg % NXCD, xcd = wgid % NXCD, off = wgid / NXCD; wgid = (xcd < r ? xcd * (q + 1) : r * (q + 1) + (xcd - r) * q) + off; }
    const int nig = WGM * nN, gid = wgid / nig, fm = gid * WGM, gsz = (nM - fm) < WGM ? (nM - fm) : WGM;
    pm = fm + ((wgid % nig) % gsz); pn = (wgid % nig) / gsz;
}

__device__ __forceinline__ unsigned cvt_pk_bf16(float lo, float hi) { return pk2(lo, hi); }

template <class Epi, class Sched, bool ALIGN_EPI, bool SP2, bool GATHER>
__device__ __forceinline__ void gemm_phase(PG8_LAS unsigned char* lds, const int K, const Sched& S, const Epi& E) {
    const int tid = threadIdx.x, wid = __builtin_amdgcn_readfirstlane(tid >> 6), lane = tid & 63, wr = wid >> 2, wc = wid & 3, fr = lane & 15, fq = lane >> 4;
    const int nt = K / BK;
    unsigned voffA[2], voffB[2];
#pragma unroll
    for (int i = 0; i < 2; ++i) { int R, C; stage_rc(tid * 16 + i * 8192, R, C); const int Rb = Epi::PERM ? ((R & ~31) + perm32(R & 31)) : R;
        voffA[i] = (unsigned)(R * K + C) * 2u; voffB[i] = (unsigned)(Rb * K + C) * 2u; }
    unsigned gA[2][2];
    const size_t kstep = (size_t)(BK * 2);
    const size_t hstep = (size_t)HALF * K * 2;
    const unsigned ldsw = (unsigned)wid * 1024u;
    const int aoff = lds_byte(wr * 64 + fr, fq * 8), boff = lds_byte(wc * 32 + fr, fq * 8);
#define PG8_SA(b, h) (((b) * 2 + (h)) * HTB)
#define PG8_SB(b, h) ((4 + (b) * 2 + (h)) * HTB)
#define PG8_STAGE(bufoff, gbase, voff) do { _Pragma("unroll") for (int _i = 0; _i < 2; ++_i) \
        __builtin_amdgcn_global_load_lds((const unsigned*)((const char*)(gbase) + (voff)[_i]), (PG8_LAS unsigned*)(lds + (bufoff) + ldsw + _i * 8192), 16, 0, 0); } while (0)
#define PG8_STAGE_A(bufoff, kptr, h, NX) do { if constexpr (GATHER) { PG8_STAGE(bufoff, kptr, gA[h]); } else PG8_STAGE(bufoff, (kptr) + (h) * hstep, voffA); } while (0)
#define PG8_LDA(dst, b, h) do { _Pragma("unroll") for (int m = 0; m < 4; ++m) _Pragma("unroll") for (int k = 0; k < 2; ++k) dst[m][k] = *(const PG8_LAS bf16x8*)(lds + PG8_SA(b, h) + aoff + m * 2048 + k * 1024); } while (0)
#define PG8_LDB(dst, b, h) do { _Pragma("unroll") for (int n = 0; n < 2; ++n) _Pragma("unroll") for (int k = 0; k < 2; ++k) dst[n][k] = *(const PG8_LAS bf16x8*)(lds + PG8_SB(b, h) + boff + n * 2048 + k * 1024); } while (0)
#define PG8_MMA(ai, bj, At, Bt) do { __builtin_amdgcn_s_setprio(1); _Pragma("unroll") for (int m = 0; m < 4; ++m) _Pragma("unroll") for (int n = 0; n < 2; ++n) _Pragma("unroll") for (int k = 0; k < 2; ++k) \
        acc[ai][bj][m][n] = __builtin_amdgcn_mfma_f32_16x16x32_bf16(Bt[n][k], At[m][k], acc[ai][bj][m][n], 0, 0, 0); __builtin_amdgcn_s_setprio(0); } while (0)
#define PG8_WAIT_V(n) asm volatile("s_waitcnt vmcnt(" #n ")" ::: "memory")
#define PG8_WAIT_L(n) asm volatile("s_waitcnt lgkmcnt(" #n ")" ::: "memory")
#define PG8_BAR __builtin_amdgcn_s_barrier()
#define PG8_SCHED __builtin_amdgcn_sched_barrier(0)
#define PG8_GOFF(dst, u) do { if constexpr (GATHER) { _Pragma("unroll") for (int _i = 0; _i < 2; ++_i) { int _R, _C; stage_rc(tid * 16 + _i * 8192, _R, _C); \
        _Pragma("unroll") for (int _h = 0; _h < 2; ++_h) { const int _r = _h * HALF + _R; const int _t = _r < (u).nrows ? (u).rows[_r] : 0; dst[_h][_i] = (unsigned)(_t * K + _C) * 2u; } } } } while (0)
    Unit cur, nxt; int ui = 0;
    if (!S.next(0, cur)) return;
    f32x4 acc[2][2][4][2];
#pragma unroll
    for (int a = 0; a < 2; ++a)
#pragma unroll
        for (int b = 0; b < 2; ++b)
#pragma unroll
            for (int m = 0; m < 4; ++m)
#pragma unroll
                for (int n = 0; n < 2; ++n) acc[a][b][m][n] = (f32x4){0.f, 0.f, 0.f, 0.f};
    bf16x8 At[4][2], B0[2][2], B1[2][2];
    const char* cA = cur.a; const char* cB = cur.b;
    PG8_GOFF(gA, cur);
    if constexpr (SP2) {
        PG8_STAGE(PG8_SB(0, 0), cB, voffB); PG8_STAGE(PG8_SB(0, 1), cB + hstep, voffB); PG8_STAGE_A(PG8_SA(0, 0), cA, 0, false); PG8_STAGE_A(PG8_SA(0, 1), cA, 1, false);
        if (wr == 1) PG8_BAR;
        PG8_WAIT_V(2); PG8_BAR;
        PG8_STAGE(PG8_SB(1, 0), cB + kstep, voffB); PG8_STAGE_A(PG8_SA(1, 0), cA + kstep, 0, false); PG8_STAGE(PG8_SB(1, 1), cB + hstep + kstep, voffB);
        PG8_WAIT_V(6); PG8_BAR;
    }
    for (;;) {
        const bool has_next = S.next(ui + 1, nxt);
        const char* nA = has_next ? nxt.a : cA; const char* nB = has_next ? nxt.b : cB;
        for (int t = 0; t < nt; t += 2) {
            const bool last = (t == nt - 2);
            const char* a1 = cA + (size_t)(t + 1) * kstep;
            const char* a2 = last ? nA : cA + (size_t)(t + 2) * kstep; const char* b2 = last ? nB : cB + (size_t)(t + 2) * kstep;
            const char* a3 = a2 + kstep; const char* b3 = b2 + kstep;
            const bool NX = last;
            if constexpr (SP2) {
            PG8_LDB(B0, 0, 0); PG8_LDB(B1, 0, 1); PG8_SCHED; PG8_LDA(At, 0, 0); PG8_STAGE_A(PG8_SA(1, 1), a1, 1, false);
            if (last && has_next) PG8_GOFF(gA, nxt);
            PG8_WAIT_V(8); PG8_WAIT_L(0); PG8_BAR; PG8_MMA(0, 0, At, B0); PG8_MMA(0, 1, At, B1); PG8_BAR; PG8_SCHED;
            PG8_LDA(At, 0, 1); PG8_STAGE(PG8_SB(0, 0), b2, voffB); PG8_STAGE(PG8_SB(0, 1), b2 + hstep, voffB); PG8_STAGE_A(PG8_SA(0, 0), a2, 0, NX);
            PG8_WAIT_V(8); PG8_WAIT_L(0); PG8_BAR; PG8_MMA(1, 0, At, B0); PG8_MMA(1, 1, At, B1); PG8_BAR; PG8_SCHED;
            PG8_LDB(B0, 1, 0); PG8_LDB(B1, 1, 1); PG8_SCHED; PG8_LDA(At, 1, 0); PG8_STAGE_A(PG8_SA(0, 1), a2, 1, NX);
            PG8_WAIT_V(8); PG8_WAIT_L(0); PG8_BAR; PG8_MMA(0, 0, At, B0); PG8_MMA(0, 1, At, B1); PG8_BAR; PG8_SCHED;
            PG8_LDA(At, 1, 1); PG8_STAGE(PG8_SB(1, 0), b3, voffB); PG8_STAGE(PG8_SB(1, 1), b3 + hstep, voffB); PG8_STAGE_A(PG8_SA(1, 0), a3, 0, NX);
            PG8_WAIT_V(8); PG8_WAIT_L(0); PG8_BAR; PG8_MMA(1, 0, At, B0); PG8_MMA(1, 1, At, B1); PG8_BAR; PG8_SCHED;
            }
        }
        if constexpr (ALIGN_EPI) { if (wr == 0) PG8_BAR; }
        const bool keep = E(acc, cur, wr, wc, fr, fq);
        if (!has_next) break;
        if (!keep)
#pragma unroll
        for (int a = 0; a < 2; ++a)
#pragma unroll
            for (int b = 0; b < 2; ++b)
#pragma unroll
                for (int m = 0; m < 4; ++m)
#pragma unroll
                    for (int n = 0; n < 2; ++n) acc[a][b][m][n] = (f32x4){0.f, 0.f, 0.f, 0.f};
        cur = nxt; cA = nA; cB = nB; ++ui;
        if constexpr (ALIGN_EPI) { if (wr == 1) PG8_BAR; }
    }
    PG8_WAIT_V(0);
    if constexpr (!ALIGN_EPI) { if (wr == 0) PG8_BAR; }
    PG8_BAR;
#undef PG8_SA
#undef PG8_SB
#undef PG8_STAGE
#undef PG8_STAGE_A
#undef PG8_LDA
#undef PG8_LDB
#undef PG8_MMA
#undef PG8_WAIT_V
#undef PG8_WAIT_L
#undef PG8_BAR
#undef PG8_SCHED
#undef PG8_GOFF
}
}
#define XB_TMO      128
#define XB_XCNT(j)  (256  + 64 * (j))
#define XB_XSUB(j)  (1280 + 64 * (j))
#define XB_XGEN(j)  (2304 + 64 * (j))
#define XB_TOP      3328
#define XB_TOPGEN   3392
#define XCD_BAR_WORDS 3456
#define XB_SPIN_CAP (1u << 18)

__device__ __forceinline__ unsigned xb_ld(unsigned* p)              { return __hip_atomic_load(p, __ATOMIC_RELAXED, __HIP_MEMORY_SCOPE_AGENT); }
__device__ __forceinline__ unsigned xb_add(unsigned* p, unsigned v) { return __hip_atomic_fetch_add(p, v, __ATOMIC_RELAXED, __HIP_MEMORY_SCOPE_AGENT); }
__device__ __forceinline__ unsigned xb_xcc_id() { return (unsigned)__builtin_amdgcn_s_getreg((3 << 11) | 20) & 0xFu; }
#define XB_SPIN(cond, bar) do { unsigned _sp = 0; while (cond) { __builtin_amdgcn_s_sleep(1); \
    if ((++_sp & 255u) == 0u) { if (xb_ld(&(bar)[XB_TMO])) break; if (_sp > XB_SPIN_CAP) { atomicAdd(&(bar)[XB_TMO], 1u); break; } } } } while (0)

struct XcdBarrier {
    unsigned* bar; unsigned x;
    volatile LAS unsigned* st;
};
__device__ __forceinline__ XcdBarrier xcd_barrier_post(unsigned* bar, volatile LAS unsigned* st) {
    XcdBarrier b; b.bar = bar; b.x = xb_xcc_id(); b.st = st;
    if (threadIdx.x == 0) (void)xb_add(&bar[XB_XCNT(b.x)], 1u);
    return b;
}
__device__ __forceinline__ void xcd_barrier_complete(unsigned* bar, unsigned x, unsigned& nloc, unsigned& nx) {
    const unsigned G = gridDim.x * gridDim.y * gridDim.z;
    unsigned sum, cnt, mine, sp = 0u;
    for (;;) {
        sum = 0u; cnt = 0u; mine = 0u;
#pragma unroll
        for (unsigned j = 0; j < 16; ++j) { const unsigned c = xb_ld(&bar[XB_XCNT(j)]); sum += c; cnt += (c > 0u) ? 1u : 0u; mine = (j == x) ? c : mine; }
        if (sum == G) break;
        __builtin_amdgcn_s_sleep(1);
        if ((++sp & 255u) == 0u) { if (xb_ld(&bar[XB_TMO])) break; if (sp > XB_SPIN_CAP) { atomicAdd(&bar[XB_TMO], 1u); break; } }
    }
    nloc = mine > 0u ? mine : 1u; nx = cnt > 0u ? cnt : 1u;
}
__device__ __forceinline__ void xcd_barrier(const XcdBarrier& b) {
    asm volatile("s_waitcnt vmcnt(0)" ::: "memory");
    __syncthreads();
    if (threadIdx.x == 0) {
        unsigned* bar = b.bar;
        __builtin_amdgcn_s_waitcnt(0);
        unsigned nloc = b.st[0], nx = b.st[1];
        if (nloc == 0u) { xcd_barrier_complete(bar, b.x, nloc, nx); b.st[0] = nloc; b.st[1] = nx; }
        const unsigned old = xb_add(&bar[XB_XSUB(b.x)], 1u);
        const unsigned gen = old / nloc;
        if (old + 1u == (gen + 1u) * nloc) {
            __builtin_amdgcn_fence(__ATOMIC_RELEASE, "agent");
            asm volatile("s_waitcnt vmcnt(0)" ::: "memory");
            const unsigned og = xb_add(&bar[XB_TOP], 1u);
            const unsigned tg = og / nx;
            if (og + 1u == (tg + 1u) * nx) xb_add(&bar[XB_TOPGEN], 1u);
            else XB_SPIN(xb_ld(&bar[XB_TOPGEN]) == tg, bar);
            __builtin_amdgcn_fence(__ATOMIC_ACQUIRE, "agent");
            xb_add(&bar[XB_XGEN(b.x)], 1u);
            asm volatile("s_waitcnt vmcnt(0)" ::: "memory");
        } else {
            XB_SPIN(xb_ld(&bar[XB_XGEN(b.x)]) == gen, bar);
            __builtin_amdgcn_fence(__ATOMIC_ACQUIRE, "agent");
            asm volatile("s_waitcnt vmcnt(0)" ::: "memory");
        }
    }
    __syncthreads();
}

struct Args { const float* in[27]; float* out; unsigned char* ws; int ph_lo, ph_hi, use_bar, pad; };
struct Frame {
    LAS unsigned char* lds; volatile LAS unsigned* MISC; gu32* ctl; unsigned char* ws;
    int tid, lane, wave, vcu, G;
    unsigned long long tp0, tp1;
};
#ifndef PROBE_A
#define PROBE_A -1
#define PROBE_B -1
#endif
#define STAMP(F, id) do { if (PROBE_A >= 0) { if ((id) == PROBE_A) (F).tp0 = __builtin_amdgcn_s_memrealtime(); if ((id) == PROBE_B) (F).tp1 = __builtin_amdgcn_s_memrealtime(); } } while (0)

__device__ __forceinline__ void fourier_table_item(unsigned char* ws, int f, int lane);
__device__ __forceinline__ void router_table_item(unsigned char* ws, const float* wgrp, const float* wer, int f, int lane);
struct TrDesc { const float* src; bf16* dst; int ldw, ldk; };
constexpr int T_IN = 16 * 112, T_FO = 8 * 32, T_LO = 8 * 32, T_OUT = 16 * 32, T_SMALL = T_IN + T_FO + T_LO + T_OUT, T_GU = 32 * 2 * 16 * 16, T_D = 32 * 8 * 32, T_ALL = T_SMALL + T_GU + T_D;
constexpr int T_P0 = T_SMALL + 10240;
__device__ __forceinline__ TrDesc tr_decode(const Args& a, unsigned char* ws, int r) {
    TrDesc d;
    if (r < T_IN) { const int kb = r / 112, nb = r % 112; d.src = a.in[7] + (size_t)(64 * kb) * DIN + 32 * nb; d.ldw = DIN; d.dst = (bf16*)(ws + WS_WIN) + (size_t)(32 * nb) * 1024 + 64 * kb; d.ldk = 1024; return d; } r -= T_IN;
    if (r < T_FO) { const int kb = r / 32, nb = r % 32; d.src = a.in[15] + (size_t)(64 * kb) * 1024 + 32 * nb; d.ldw = 1024; d.dst = (bf16*)(ws + WS_WFO) + (size_t)(32 * nb) * 512 + 64 * kb; d.ldk = 512; return d; } r -= T_FO;
    if (r < T_LO) { const int kb = r / 32, nb = r % 32; d.src = a.in[16] + (size_t)(64 * kb) * 1024 + 32 * nb; d.ldw = 1024; d.dst = (bf16*)(ws + WS_WLO) + (size_t)(32 * nb) * 512 + 64 * kb; d.ldk = 512; return d; } r -= T_LO;
    if (r < T_OUT) { const int kb = r / 32, nb = r % 32; d.src = a.in[17] + (size_t)(64 * kb) * 1024 + 32 * nb; d.ldw = 1024; d.dst = (bf16*)(ws + WS_WOUT) + (size_t)(32 * nb) * 1024 + 64 * kb; d.ldk = 1024; return d; } r -= T_OUT;
    if (r < T_GU) { const int e = r >> 9, up = (r >> 8) & 1, q = r & 255, kb = q >> 4, nb = q & 15, n0 = 32 * nb, row = (n0 >> 7) * 256 + up * 128 + (n0 & 127);
        d.src = (up ? a.in[24] : a.in[23]) + (size_t)e * 1024 * 512 + (size_t)(64 * kb) * 512 + n0; d.ldw = 512; d.dst = (bf16*)(ws + WS_WGU) + ((size_t)e * 1024 + row) * 1024 + 64 * kb; d.ldk = 1024; return d; } r -= T_GU;
    { const int e = r >> 8, q = r & 255, kb = q >> 5, nb = q & 31;
        d.src = a.in[25] + (size_t)e * 512 * 1024 + (size_t)(64 * kb) * 1024 + 32 * nb; d.ldw = 1024; d.dst = (bf16*)(ws + WS_WD) + ((size_t)e * 1024 + 32 * nb) * 512 + 64 * kb; d.ldk = 512; return d; }
}
__device__ __forceinline__ void tr_load(const TrDesc& d, int lane, f32x4 (&v)[8]) {
#pragma unroll
    for (int it = 0; it < 8; ++it) { const int kk = it * 8 + (lane >> 3); v[it] = *(const GAS f32x4*)(d.src + (size_t)kk * d.ldw + 4 * (lane & 7)); }
}
__device__ __forceinline__ void tr_store(const TrDesc& d, int lane, const f32x4 (&v)[8], LAS float* scr) {
#pragma unroll
    for (int it = 0; it < 8; ++it) { const int kk = it * 8 + (lane >> 3); LAS float* p = scr + kk * 33 + 4 * (lane & 7); p[0] = v[it].x; p[1] = v[it].y; p[2] = v[it].z; p[3] = v[it].w; }
    LDS_WAIT(); asm volatile("" ::: "memory");
    const int c = lane & 7;
#pragma unroll
    for (int j = 0; j < 4; ++j) { const int n = (lane >> 3) + 8 * j; const LAS float* s = scr + (8 * c) * 33 + n;
        v4u o; o.x = pk2(s[0 * 33], s[1 * 33]); o.y = pk2(s[2 * 33], s[3 * 33]); o.z = pk2(s[4 * 33], s[5 * 33]); o.w = pk2(s[6 * 33], s[7 * 33]);
        *(GAS v4u*)(d.dst + (size_t)n * d.ldk + 8 * c) = o; }
    LDS_WAIT(); asm volatile("" ::: "memory");
}
__device__ __forceinline__ void tr_run(const Args& a, unsigned char* ws, int first, int step, int end, int lane, LAS float* scr) {
    if (first >= end) return;
    TrDesc cur = tr_decode(a, ws, first); f32x4 v[8]; tr_load(cur, lane, v);
    for (int it = first; it < end; it += step) {
        const int nx = it + step; TrDesc nd = cur; f32x4 vn[8];
        if (nx < end) { nd = tr_decode(a, ws, nx); tr_load(nd, lane, vn); }
        tr_store(cur, lane, v, scr);
        if (nx < end) { cur = nd;
#pragma unroll
            for (int q = 0; q < 8; ++q) v[q] = vn[q]; }
    }
}
constexpr int SIL_STRIDE = 1056;
__device__ __forceinline__ void p0_prologue(Frame& F, const Args& a) {
    const float* c = a.in[1]; const float* cctx = a.in[3]; const float* wmod = a.in[4]; const float* bmod = a.in[5];
    const float* lwa = a.in[10]; const float* lwx = a.in[12];
    LAS float* sil = (LAS float*)(F.lds);
    LAS float* scr = (LAS float*)(F.lds + 73728 + F.wave * 8448);
    for (int i = F.tid; i < 17 * 1024; i += NWAVES * 64) { const int r = i >> 10, k = i & 1023; const float v = r < 16 ? c[r * 1024 + k] : cctx[k];
        sil[r * SIL_STRIDE + k + 8 * (k >> 8)] = v / (1.f + expf(-v)); }
    __syncthreads();
    {
        LAS float* red = (LAS float*)(F.lds + 73728 + NWAVES * 8448);
        float* mod = (float*)(F.ws + WS_MOD);
        for (int item = (int)blockIdx.x; item < 384; item += F.G) {
            const int c0 = item * 16, ci = F.lane & 15, kq = F.lane >> 4, kb = 128 * F.wave + 32 * kq;
            const float* wp = wmod + (size_t)kb * 6144 + c0 + ci;
            float acc[17];
#pragma unroll
            for (int r = 0; r < 17; ++r) acc[r] = 0.f;
#pragma unroll 1
            for (int grp = 0; grp < 2; ++grp) {
                float w[16];
#pragma unroll
                for (int j = 0; j < 16; ++j) w[j] = wp[(size_t)(16 * grp + j) * 6144];
#pragma unroll
                for (int j4 = 0; j4 < 4; ++j4) {
#pragma unroll
                    for (int r = 0; r < 17; ++r) { const int k = kb + 16 * grp + 4 * j4; const f32x4 s = *(const LAS f32x4*)(sil + r * SIL_STRIDE + k + 8 * (k >> 8));
                        acc[r] += s[0] * w[4 * j4]; acc[r] += s[1] * w[4 * j4 + 1]; acc[r] += s[2] * w[4 * j4 + 2]; acc[r] += s[3] * w[4 * j4 + 3]; }
                    asm volatile("" ::: "memory"); }
            }
#pragma unroll
            for (int r = 0; r < 17; ++r) { float v = acc[r]; v += __shfl_xor(v, 16); v += __shfl_xor(v, 32); if (kq == 0) red[(F.wave * 17 + r) * 16 + ci] = v; }
            __syncthreads();
            if (F.tid < 17 * 16) { const int r = F.tid >> 4, cc = F.tid & 15; float v = 0.f;
#pragma unroll
                for (int ww = 0; ww < NWAVES; ++ww) v += red[(ww * 17 + r) * 16 + cc];
                mod[r * 6144 + c0 + cc] = v + bmod[c0 + cc]; }
            __syncthreads();
        }
    }
    if (blockIdx.x == F.G - 1) { const float* lba = a.in[11]; const float* lbx = a.in[13]; const float* lam = a.in[14]; f32x4* LC = (f32x4*)(F.ws + WS_WLRU + 512 * 1024);
        for (int q = F.tid; q < 1024; q += NWAVES * 64) LC[q] = (f32x4){-1.4426950409f * lba[q], -1.4426950409f * lbx[q], 8.f * log1pf(expf(-lam[q])), 0.f}; }
    const int gw = F.vcu * NWAVES + F.wave, NGW = F.G * NWAVES;
    constexpr int I_LRU = 256, I_FT = 96, I_RT = 96;
    bf16* WLRU = (bf16*)(F.ws + WS_WLRU);
    for (int r = NGW - 1 - gw; r < I_LRU + I_FT + I_RT; r += NGW) {
        if (r >= I_LRU + I_FT) { router_table_item(F.ws, a.in[19], a.in[21], r - I_LRU - I_FT, F.lane); continue; }
        if (r >= I_LRU) { fourier_table_item(F.ws, r - I_LRU, F.lane); continue; }
        {
            const int s = r & 1, ct = (r >> 1) & 3, type = (r >> 3) & 1, d = (r >> 4) & 1, h = r >> 5, i = F.lane & 15, g = F.lane >> 4;
            const float* W = (type ? lwx : lwa) + ((size_t)(d * 8 + h) * 64) * 64;
            float v[8];
#pragma unroll
            for (int j = 0; j < 8; ++j) v[j] = -1.4426950409f * W[(32 * s + 8 * g + j) * 64 + 16 * ct + i];
            v4u o; o.x = pk2(v[0], v[1]); o.y = pk2(v[2], v[3]); o.z = pk2(v[4], v[5]); o.w = pk2(v[6], v[7]);
            *(GAS v4u*)(WLRU + (size_t)r * 512 + F.lane * 8) = o;
        }
    }
    tr_run(a, F.ws, gw, NGW, T_P0, F.lane, scr);
}

__device__ __forceinline__ void p1_normmod(Frame& F, const Args& a) {
    const float* x = a.in[0]; const float* ctx = a.in[2]; const float* g = a.in[6]; const float* mod = (const float*)(F.ws + WS_MOD);
    bf16* HX = (bf16*)(F.ws + WS_HX);
    const int gw = F.vcu * NWAVES + F.wave, NGW = F.G * NWAVES;
    const int per = (NTC + NGW - 1) / NGW;
    int curmr = -1; f32x4 A[4], B[4];
    for (int v = gw * per; v < (gw + 1) * per && v < NTC; ++v) {
        const int mr = v < NT ? v / SEQ : 16;
        if (mr != curmr) { curmr = mr;
#pragma unroll
            for (int j = 0; j < 4; ++j) { const int col = 4 * F.lane + 256 * j; const f32x4 gg = *(const f32x4*)(g + col), sc = *(const f32x4*)(mod + mr * 6144 + 1024 + col);
                A[j] = gg * (1.f + sc); B[j] = *(const f32x4*)(mod + mr * 6144 + col); } }
        const float* src = v < NT ? x + (size_t)v * D : ctx + (size_t)(v - NT) * D;
        const GAS f32x4* xr = (const GAS f32x4*)src + F.lane;
        f32x4 t[4]; float ss = 0.f;
#pragma unroll
        for (int j = 0; j < 4; ++j) { t[j] = xr[64 * j]; ss += (t[j].x * t[j].x + t[j].y * t[j].y) + (t[j].z * t[j].z + t[j].w * t[j].w); }
        const float rstd = rsqrtf(wave_sum(ss) * (1.f / D) + EPS);
        GAS v2u* o8 = (GAS v2u*)(HX + (size_t)v * D) + F.lane;
#pragma unroll
        for (int j = 0; j < 4; ++j) { const f32x4 y = t[j] * rstd * A[j] + B[j]; v2u w; w.x = pk2(y.x, y.y); w.y = pk2(y.z, y.w); o8[64 * j] = w; }
    }
}

struct ProjSched {
    const char* A; const char* Bt; int G, c;
    __device__ __forceinline__ bool next(int i, pg8::Unit& u) const {
        const int L = i * G + c;
        if (L < 128 * 14) pg8::static_tile(L, 128, 14, u.pm, u.pn);
        else { const int q = L - 128 * 14; if (q >= 32) return false; u.pm = 128 + (q >> 1); u.pn = 2 + (q & 1); }
        u.a = A + (size_t)u.pm * 256 * 1024 * 2; u.b = Bt + (size_t)u.pn * 256 * 1024 * 2; u.rows = nullptr; u.nrows = 0; u.aux = 0; return true;
    }
};
struct EpiProj {
    static constexpr bool PERM = true;
    unsigned char* ws;
    __device__ __forceinline__ bool operator()(f32x4 (&acc)[2][2][4][2], const pg8::Unit& u, int wr, int wc, int fr, int fq) const {
        bf16* base; int ldc, colt, act;
        if (u.pn < 2) { base = (bf16*)(ws + WS_UF); ldc = 512; colt = 256 * u.pn; act = 0; }
        else if (u.pn < 4) { base = (bf16*)(ws + WS_UR); ldc = 512; colt = 256 * (u.pn - 2); act = 0; }
        else if (u.pn < 6) { base = (bf16*)(ws + WS_GY); ldc = 512; colt = 256 * (u.pn - 4); act = 1; }
        else if (u.pn < 10) { base = (bf16*)(ws + WS_GF); ldc = 1024; colt = 256 * (u.pn - 6); act = 2; }
        else { base = (bf16*)(ws + WS_GR); ldc = 1024; colt = 256 * (u.pn - 10); act = 2; }
        const int row0 = u.pm * 256 + wr * 64 + fr, col0 = colt + wc * 32 + 8 * fq;
#pragma unroll
        for (int ai = 0; ai < 2; ++ai)
#pragma unroll
            for (int m = 0; m < 4; ++m) { bf16* rowp = base + (size_t)(row0 + ai * 128 + m * 16) * ldc + col0;
#pragma unroll
                for (int bj = 0; bj < 2; ++bj) { f32x4 v0 = acc[ai][bj][m][0], v1 = acc[ai][bj][m][1];
                    if (act == 1) {
#pragma unroll
                        for (int j = 0; j < 4; ++j) { v0[j] = fast_gelu_tanh(v0[j]); v1[j] = fast_gelu_tanh(v1[j]); } }
                    else if (act == 2) {
#pragma unroll
                        for (int j = 0; j < 4; ++j) { v0[j] = fast_sigmoid(v0[j]); v1[j] = fast_sigmoid(v1[j]); } }
                    pg8::u32x4 w; w.x = pg8::cvt_pk_bf16(v0[0], v0[1]); w.y = pg8::cvt_pk_bf16(v0[2], v0[3]); w.z = pg8::cvt_pk_bf16(v1[0], v1[1]); w.w = pg8::cvt_pk_bf16(v1[2], v1[3]);
                    *(pg8::u32x4*)(rowp + bj * 128) = w; } }
        return false;
    }
};
struct PlainSched {
    const char* A; const char* Bt; int nM, nN, K, G, c;
    __device__ __forceinline__ bool next(int i, pg8::Unit& u) const {
        const int L = i * G + c; if (L >= nM * nN) return false;
        pg8::static_tile(L, nM, nN, u.pm, u.pn);
        u.a = A + (size_t)u.pm * 256 * K * 2; u.b = Bt + (size_t)u.pn * 256 * K * 2; u.rows = nullptr; u.nrows = 0; u.aux = 0; return true;
    }
};
struct EpiGate1 {
    static constexpr bool PERM = true;
    const bf16* GF; bf16* P1;
    __device__ __forceinline__ bool operator()(f32x4 (&acc)[2][2][4][2], const pg8::Unit& u, int wr, int wc, int fr, int fq) const {
        const int row0 = u.pm * 256 + wr * 64 + fr, col0 = u.pn * 256 + wc * 32 + 8 * fq;
#pragma unroll
        for (int ai = 0; ai < 2; ++ai)
#pragma unroll
            for (int m = 0; m < 4; ++m) { const size_t ro = (size_t)(row0 + ai * 128 + m * 16) * 1024 + col0;
#pragma unroll
                for (int bj = 0; bj < 2; ++bj) { const pg8::u32x4 g = *(const pg8::u32x4*)(GF + ro + bj * 128);
                    const f32x4 v0 = acc[ai][bj][m][0], v1 = acc[ai][bj][m][1]; pg8::u32x4 w;
                    w.x = pg8::cvt_pk_bf16(v0[0] * bf2f(g.x & 0xffffu), v0[1] * bf2f(g.x >> 16)); w.y = pg8::cvt_pk_bf16(v0[2] * bf2f(g.y & 0xffffu), v0[3] * bf2f(g.y >> 16));
                    w.z = pg8::cvt_pk_bf16(v1[0] * bf2f(g.z & 0xffffu), v1[1] * bf2f(g.z >> 16)); w.w = pg8::cvt_pk_bf16(v1[2] * bf2f(g.w & 0xffffu), v1[3] * bf2f(g.w >> 16));
                    *(pg8::u32x4*)(P1 + ro + bj * 128) = w; } }
        return false;
    }
};
struct EpiGate2 {
    static constexpr bool PERM = true;
    const bf16* GR; const bf16* P1; bf16* MG;
    __device__ __forceinline__ bool operator()(f32x4 (&acc)[2][2][4][2], const pg8::Unit& u, int wr, int wc, int fr, int fq) const {
        const int row0 = u.pm * 256 + wr * 64 + fr, col0 = u.pn * 256 + wc * 32 + 8 * fq;
#pragma unroll
        for (int ai = 0; ai < 2; ++ai)
#pragma unroll
            for (int m = 0; m < 4; ++m) { const size_t ro = (size_t)(row0 + ai * 128 + m * 16) * 1024 + col0;
#pragma unroll
                for (int bj = 0; bj < 2; ++bj) { const pg8::u32x4 g = *(const pg8::u32x4*)(GR + ro + bj * 128), p = *(const pg8::u32x4*)(P1 + ro + bj * 128);
                    const f32x4 v0 = acc[ai][bj][m][0], v1 = acc[ai][bj][m][1]; pg8::u32x4 w;
                    w.x = pg8::cvt_pk_bf16(bf2f(p.x & 0xffffu) + v0[0] * bf2f(g.x & 0xffffu), bf2f(p.x >> 16) + v0[1] * bf2f(g.x >> 16));
                    w.y = pg8::cvt_pk_bf16(bf2f(p.y & 0xffffu) + v0[2] * bf2f(g.y & 0xffffu), bf2f(p.y >> 16) + v0[3] * bf2f(g.y >> 16));
                    w.z = pg8::cvt_pk_bf16(bf2f(p.z & 0xffffu) + v1[0] * bf2f(g.z & 0xffffu), bf2f(p.z >> 16) + v1[1] * bf2f(g.z >> 16));
                    w.w = pg8::cvt_pk_bf16(bf2f(p.w & 0xffffu) + v1[2] * bf2f(g.w & 0xffffu), bf2f(p.w >> 16) + v1[3] * bf2f(g.w >> 16));
                    *(pg8::u32x4*)(MG + ro + bj * 128) = w; } }
        return false;
    }
};
struct EpiOut {
    static constexpr bool PERM = false;
    const float* x; const float* mod; float* out;
    __device__ __forceinline__ bool operator()(f32x4 (&acc)[2][2][4][2], const pg8::Unit& u, int wr, int wc, int fr, int fq) const {
        const int row0 = u.pm * 256 + wr * 64 + fr, col0 = u.pn * 256 + wc * 32 + 4 * fq; const float* g1 = mod + (u.pm >> 3) * 6144 + 2048;
        f32x4 gv[2][2];
#pragma unroll
        for (int bj = 0; bj < 2; ++bj)
#pragma unroll
            for (int n = 0; n < 2; ++n) gv[bj][n] = *(const f32x4*)(g1 + col0 + bj * 128 + n * 16);
#pragma unroll
        for (int ai = 0; ai < 2; ++ai)
#pragma unroll
            for (int m = 0; m < 4; ++m) { const size_t ro = (size_t)(row0 + ai * 128 + m * 16) * 1024 + col0;
#pragma unroll
                for (int bj = 0; bj < 2; ++bj)
#pragma unroll
                    for (int n = 0; n < 2; ++n) { const f32x4 xv = *(const f32x4*)(x + ro + bj * 128 + n * 16); *(f32x4*)(out + ro + bj * 128 + n * 16) = xv + gv[bj][n] * acc[ai][bj][m][n]; }
                asm volatile("" ::: "memory"); }
        return false;
    }
};
__device__ __forceinline__ void moe_tables(Frame& F) {
    if (F.tid < 64) { const int e = F.tid & 31; int tl = ((int)__hip_atomic_load(F.ctl + CW_CNT + e, RLX_AGENT) + 255) >> 8; int incl = tl;
#pragma unroll
        for (int o = 1; o < 32; o <<= 1) { const int v = __shfl_up(incl, o, 32); if (e >= o) incl += v; }
        if (F.tid < 32) { F.MISC[64 + e] = (unsigned)(incl - tl); if (e == 31) F.MISC[96] = (unsigned)incl; } }
    __syncthreads();
}
template <bool FIRST> struct MoeSched {
    volatile LAS unsigned* toff; const unsigned* cnt; const char* T; const int* lists; const char* H; const char* W; int G, c;
    __device__ __forceinline__ bool next(int i, pg8::Unit& u) const {
        const int L = i * G + c; const int total = (int)toff[32] * 4; if (L >= total) return false;
        const int t = L >> 2; u.pn = L & 3; int e = 0;
#pragma unroll
        for (int st = 16; st >= 1; st >>= 1) if ((int)toff[e + st] <= t) e += st;
        const int tile = t - (int)toff[e]; u.pm = t; u.aux = e;
        if (FIRST) { u.a = T; u.rows = lists + e * LIST_CAP + tile * 256; const int left = (int)cnt[e] - tile * 256; u.nrows = left < 256 ? left : 256;
            u.b = W + ((size_t)e * 1024 + (size_t)u.pn * 256) * 1024 * 2; }
        else { u.a = H + (size_t)t * 256 * 512 * 2; u.rows = nullptr; u.nrows = 0; u.b = W + ((size_t)e * 1024 + (size_t)u.pn * 256) * 512 * 2; }
        return true;
    }
};
struct EpiMoe1 {
    static constexpr bool PERM = true;
    bf16* H;
    __device__ __forceinline__ bool operator()(f32x4 (&acc)[2][2][4][2], const pg8::Unit& u, int wr, int wc, int fr, int fq) const {
        const int row0 = u.pm * 256 + wr * 64 + fr, col0 = u.pn * 128 + wc * 32 + 8 * fq;
#pragma unroll
        for (int ai = 0; ai < 2; ++ai)
#pragma unroll
            for (int m = 0; m < 4; ++m) { const f32x4 g0 = acc[ai][0][m][0], g1 = acc[ai][0][m][1], u0 = acc[ai][1][m][0], u1 = acc[ai][1][m][1]; pg8::u32x4 w;
                w.x = pg8::cvt_pk_bf16(fast_silu(g0[0]) * u0[0], fast_silu(g0[1]) * u0[1]); w.y = pg8::cvt_pk_bf16(fast_silu(g0[2]) * u0[2], fast_silu(g0[3]) * u0[3]);
                w.z = pg8::cvt_pk_bf16(fast_silu(g1[0]) * u1[0], fast_silu(g1[1]) * u1[1]); w.w = pg8::cvt_pk_bf16(fast_silu(g1[2]) * u1[2], fast_silu(g1[3]) * u1[3]);
                *(pg8::u32x4*)(H + (size_t)(row0 + ai * 128 + m * 16) * 512 + col0) = w; }
        return false;
    }
};
struct EpiY {
    static constexpr bool PERM = true;
    bf16* Y;
    __device__ __forceinline__ bool operator()(f32x4 (&acc)[2][2][4][2], const pg8::Unit& u, int wr, int wc, int fr, int fq) const {
        const int row0 = u.pm * 256 + wr * 64 + fr, col0 = u.pn * 256 + wc * 32 + 8 * fq;
#pragma unroll
        for (int ai = 0; ai < 2; ++ai)
#pragma unroll
            for (int m = 0; m < 4; ++m)
#pragma unroll
                for (int bj = 0; bj < 2; ++bj) { const f32x4 v0 = acc[ai][bj][m][0], v1 = acc[ai][bj][m][1]; pg8::u32x4 w;
                    w.x = pg8::cvt_pk_bf16(v0[0], v0[1]); w.y = pg8::cvt_pk_bf16(v0[2], v0[3]); w.z = pg8::cvt_pk_bf16(v1[0], v1[1]); w.w = pg8::cvt_pk_bf16(v1[2], v1[3]);
                    *(pg8::u32x4*)(Y + (size_t)(row0 + ai * 128 + m * 16) * 1024 + col0 + bj * 128) = w; }
        return false;
    }
};
__device__ __forceinline__ void p_final(Frame& F, const Args& a, float* dst) {
    const float* mod = (const float*)(F.ws + WS_MOD); const float* fg = a.in[26]; float* out = a.out;
    const int* tokinfo = (const int*)(F.ws + WS_TOKINFO); const bf16* Y = (const bf16*)(F.ws + WS_Y);
    const int gw = F.vcu * NWAVES + F.wave, NGW = F.G * NWAVES, per = NT / NGW;
    for (int t0 = gw * per; t0 < NT; t0 += NGW * per) {
        const int b = t0 / SEQ;
        f32x4 g2[2][2], fgv[2][2];
#pragma unroll
        for (int j = 0; j < 2; ++j)
#pragma unroll
            for (int h = 0; h < 2; ++h) { const int col = 8 * F.lane + 512 * j + 4 * h; g2[j][h] = *(const f32x4*)(mod + b * 6144 + 5120 + col); fgv[j][h] = *(const f32x4*)(fg + col); }
        for (int t = t0; t < t0 + per; ++t) {
            const int* ti = tokinfo + t * 8; const int e0 = ti[0], p0 = ti[1], e1 = ti[2], p1 = ti[3]; const float w0 = ((const float*)ti)[4], w1 = ((const float*)ti)[5];
            const bf16* y0 = Y + ((size_t)F.MISC[64 + e0] * 256 + p0) * 1024; const bf16* y1 = Y + ((size_t)F.MISC[64 + e1] * 256 + p1) * 1024;
            float* xr = out + (size_t)t * 1024;
            f32x4 v[2][2]; float ss = 0.f;
#pragma unroll
            for (int j = 0; j < 2; ++j) { const int col = 8 * F.lane + 512 * j;
                const pg8::u32x4 a0 = *(const pg8::u32x4*)(y0 + col), a1 = *(const pg8::u32x4*)(y1 + col);
                f32x4 m0, m1;
                m0[0] = w0 * bf2f(a0.x & 0xffffu) + w1 * bf2f(a1.x & 0xffffu); m0[1] = w0 * bf2f(a0.x >> 16) + w1 * bf2f(a1.x >> 16);
                m0[2] = w0 * bf2f(a0.y & 0xffffu) + w1 * bf2f(a1.y & 0xffffu); m0[3] = w0 * bf2f(a0.y >> 16) + w1 * bf2f(a1.y >> 16);
                m1[0] = w0 * bf2f(a0.z & 0xffffu) + w1 * bf2f(a1.z & 0xffffu); m1[1] = w0 * bf2f(a0.z >> 16) + w1 * bf2f(a1.z >> 16);
                m1[2] = w0 * bf2f(a0.w & 0xffffu) + w1 * bf2f(a1.w & 0xffffu); m1[3] = w0 * bf2f(a0.w >> 16) + w1 * bf2f(a1.w >> 16);
                v[j][0] = *(const f32x4*)(xr + col) + g2[j][0] * m0; v[j][1] = *(const f32x4*)(xr + col + 4) + g2[j][1] * m1;
#pragma unroll
                for (int h = 0; h < 2; ++h) ss += (v[j][h][0] * v[j][h][0] + v[j][h][1] * v[j][h][1]) + (v[j][h][2] * v[j][h][2] + v[j][h][3] * v[j][h][3]); }
            const float rstd = rsqrtf(wave_sum(ss) * (1.f / D) + EPS);
#pragma unroll
            for (int j = 0; j < 2; ++j)
#pragma unroll
                for (int h = 0; h < 2; ++h) *(f32x4*)(dst + (size_t)t * 1024 + 8 * F.lane + 512 * j + 4 * h) = v[j][h] * rstd * fgv[j][h];
        }
    }
}

struct PairSched {
    const char* A0; const char* B0; const char* A1; const char* B1; int G, c;
    __device__ __forceinline__ bool next(int i, pg8::Unit& u) const {
        const int L = (i >> 1) * G + c; if (L >= 128 * 4) return false;
        pg8::static_tile(L, 128, 4, u.pm, u.pn); u.aux = i & 1;
        u.a = (u.aux ? A1 : A0) + (size_t)u.pm * 256 * 512 * 2; u.b = (u.aux ? B1 : B0) + (size_t)u.pn * 256 * 512 * 2; u.rows = nullptr; u.nrows = 0; return true;
    }
};
struct EpiMerge {
    static constexpr bool PERM = true;
    const bf16* GF; const bf16* GR; bf16* MG;
    __device__ __forceinline__ bool operator()(f32x4 (&acc)[2][2][4][2], const pg8::Unit& u, int wr, int wc, int fr, int fq) const {
        const int row0 = u.pm * 256 + wr * 64 + fr, col0 = u.pn * 256 + wc * 32 + 8 * fq;
        if (u.aux == 0) {
#pragma unroll
            for (int ai = 0; ai < 2; ++ai)
#pragma unroll
                for (int m = 0; m < 4; ++m) { const size_t ro = (size_t)(row0 + ai * 128 + m * 16) * 1024 + col0;
#pragma unroll
                    for (int bj = 0; bj < 2; ++bj) { const pg8::u32x4 gf = *(const pg8::u32x4*)(GF + ro + bj * 128), gr = *(const pg8::u32x4*)(GR + ro + bj * 128);
                        const unsigned f[4] = {gf.x, gf.y, gf.z, gf.w}, r[4] = {gr.x, gr.y, gr.z, gr.w};
#pragma unroll
                        for (int q = 0; q < 4; ++q) { const float r0 = bf2f(f[q] & 0xffffu) * __builtin_amdgcn_rcpf(fmaxf(bf2f(r[q] & 0xffffu), 1e-30f)), r1 = bf2f(f[q] >> 16) * __builtin_amdgcn_rcpf(fmaxf(bf2f(r[q] >> 16), 1e-30f));
                            acc[ai][bj][m][q >> 1][2 * (q & 1)] *= r0; acc[ai][bj][m][q >> 1][2 * (q & 1) + 1] *= r1; } } }
            return true;
        }
#pragma unroll
        for (int ai = 0; ai < 2; ++ai)
#pragma unroll
            for (int m = 0; m < 4; ++m) { const size_t ro = (size_t)(row0 + ai * 128 + m * 16) * 1024 + col0;
#pragma unroll
                for (int bj = 0; bj < 2; ++bj) { const pg8::u32x4 g = *(const pg8::u32x4*)(GR + ro + bj * 128);
                    const f32x4 v0 = acc[ai][bj][m][0], v1 = acc[ai][bj][m][1]; pg8::u32x4 w;
                    w.x = pk2(v0[0] * bf2f(g.x & 0xffffu), v0[1] * bf2f(g.x >> 16)); w.y = pk2(v0[2] * bf2f(g.y & 0xffffu), v0[3] * bf2f(g.y >> 16));
                    w.z = pk2(v1[0] * bf2f(g.z & 0xffffu), v1[1] * bf2f(g.z >> 16)); w.w = pk2(v1[2] * bf2f(g.w & 0xffffu), v1[3] * bf2f(g.w >> 16));
                    *(pg8::u32x4*)(MG + ro + bj * 128) = w; } }
        return false;
    }
};
constexpr size_t WS_RTAB = WS_WLRU + 768 * 1024;
constexpr int RT_STRIDE = 1028;
__device__ __forceinline__ void p8_route(Frame& F, const Args& a, const bool dispatch = true) {
    const float* x1 = a.out; const float* g2n = a.in[18]; const float* mod = (const float*)(F.ws + WS_MOD);
    const float* wgrp = a.in[19]; const float* bgrp = a.in[20]; const float* wer = a.in[21]; const float* ber = a.in[22];
    bf16* T = (bf16*)(F.ws + WS_T); int* tokinfo = (int*)(F.ws + WS_TOKINFO); int* lists = (int*)(F.ws + WS_LISTS);
    LAS float* tile = (LAS float*)F.lds;
    LAS float* part = (LAS float*)(F.lds + 16 * RT_STRIDE * 4);
    LAS float* lgs = (LAS float*)(F.lds + 16 * RT_STRIDE * 4 + 8 * 16 * 48 * 4);
    LAS int* beid = (LAS int*)(F.lds + 16 * RT_STRIDE * 4 + 8 * 16 * 48 * 4 + 16 * 48 * 4);
    const int w = F.wave, lane = F.lane, i16 = lane & 15, g = lane >> 4;
    const int tpb = (NT / 16 + F.G - 1) / F.G;
    const int tile0 = (int)blockIdx.x * tpb;
    bf16x8 Whi[3][4], Wlo[3][4];
    { const GAS bf16x8* tab = (const GAS bf16x8*)(F.ws + WS_RTAB);
#pragma unroll
    for (int nt = 0; nt < 3; ++nt)
#pragma unroll
        for (int s = 0; s < 4; ++s) { const int f = (w * 3 + nt) * 4 + s; Whi[nt][s] = tab[(size_t)f * 64 + lane]; Wlo[nt][s] = tab[(size_t)(96 + f) * 64 + lane]; } }
    int curb = -1; f32x4 A2[4], B2[4];
    f32x4 tn[2][4];
    auto load_rows = [&](int tt_) {
#pragma unroll
        for (int rr = 0; rr < 2; ++rr) { const GAS f32x4* xr = (const GAS f32x4*)(x1 + (size_t)(tt_ * 16 + 2 * w + rr) * D) + lane;
#pragma unroll
            for (int j = 0; j < 4; ++j) tn[rr][j] = xr[64 * j]; } };
    if (tile0 < NT / 16) load_rows(tile0);
    for (int tl = 0; tl < tpb; ++tl) {
        const int tt = tile0 + tl; if (tt >= NT / 16) break;
        const int b = (tt * 16) / SEQ;
        if (b != curb) { curb = b;
#pragma unroll
            for (int j = 0; j < 4; ++j) { const int col = 4 * lane + 256 * j; const f32x4 gg = *(const f32x4*)(g2n + col), sc = *(const f32x4*)(mod + b * 6144 + 4096 + col);
                A2[j] = gg * (1.f + sc); B2[j] = *(const f32x4*)(mod + b * 6144 + 3072 + col); } }
#pragma unroll
        for (int rr = 0; rr < 2; ++rr) { const int r = 2 * w + rr, tok = tt * 16 + r;
            float ss = 0.f;
#pragma unroll
            for (int j = 0; j < 4; ++j) { const f32x4 t = tn[rr][j]; ss += (t.x * t.x + t.y * t.y) + (t.z * t.z + t.w * t.w); }
            const float rstd = rsqrtf(wave_sum(ss) * (1.f / D) + EPS);
            GAS v2u* o8 = (GAS v2u*)(T + (size_t)tok * D) + lane;
#pragma unroll
            for (int j = 0; j < 4; ++j) { const f32x4 y = tn[rr][j] * rstd * A2[j] + B2[j];
                *(LAS f32x4*)(tile + r * RT_STRIDE + 4 * lane + 256 * j) = y;
                v2u wv; wv.x = pk2(y.x, y.y); wv.y = pk2(y.z, y.w); o8[64 * j] = wv; } }
        if (tl + 1 < tpb && tt + 1 < NT / 16) load_rows(tt + 1);
        __syncthreads();
        f32x4 acc[3];
#pragma unroll
        for (int nt = 0; nt < 3; ++nt) acc[nt] = (f32x4){0.f, 0.f, 0.f, 0.f};
#pragma unroll
        for (int s = 0; s < 4; ++s) {
            const LAS float* p = tile + i16 * RT_STRIDE + 128 * w + 32 * s + 8 * g;
            const f32x4 v0 = *(const LAS f32x4*)p, v1 = *(const LAS f32x4*)(p + 4);
            v4u ph, pl;
            ph.x = pk2(v0[0], v0[1]); ph.y = pk2(v0[2], v0[3]); ph.z = pk2(v1[0], v1[1]); ph.w = pk2(v1[2], v1[3]);
            pl.x = pk2(v0[0] - bf2f(ph.x & 0xffffu), v0[1] - __builtin_bit_cast(float, ph.x & 0xffff0000u)); pl.y = pk2(v0[2] - bf2f(ph.y & 0xffffu), v0[3] - __builtin_bit_cast(float, ph.y & 0xffff0000u));
            pl.z = pk2(v1[0] - bf2f(ph.z & 0xffffu), v1[1] - __builtin_bit_cast(float, ph.z & 0xffff0000u)); pl.w = pk2(v1[2] - bf2f(ph.w & 0xffffu), v1[3] - __builtin_bit_cast(float, ph.w & 0xffff0000u));
            const bf16x8 Ahi = __builtin_bit_cast(bf16x8, ph), Alo = __builtin_bit_cast(bf16x8, pl);
#pragma unroll
            for (int nt = 0; nt < 3; ++nt) {
                acc[nt] = __builtin_amdgcn_mfma_f32_16x16x32_bf16(Ahi, Whi[nt][s], acc[nt], 0, 0, 0);
                acc[nt] = __builtin_amdgcn_mfma_f32_16x16x32_bf16(Ahi, Wlo[nt][s], acc[nt], 0, 0, 0);
                acc[nt] = __builtin_amdgcn_mfma_f32_16x16x32_bf16(Alo, Whi[nt][s], acc[nt], 0, 0, 0); }
        }
#pragma unroll
        for (int nt = 0; nt < 3; ++nt)
#pragma unroll
            for (int q = 0; q < 4; ++q) part[(w * 16 + 4 * g + q) * 48 + 16 * nt + i16] = acc[nt][q];
        __syncthreads();
        for (int q = F.tid; q < 16 * 48; q += NWAVES * 64) { const int r = q / 48, n = q - 48 * r; float s = 0.f;
#pragma unroll
            for (int ww = 0; ww < 8; ++ww) s += part[(ww * 16 + r) * 48 + n];
            if (n < 36) s += (n < 4 ? bgrp[n] : ber[n - 4]);
            lgs[q] = s; }
        __syncthreads();
        if (F.tid < 16) { const int r = F.tid, tok = tt * 16 + r; const LAS float* lg = lgs + r * 48;
            int grp = 0; float mx = lg[0];
            for (int q = 1; q < 4; ++q) { const float v = lg[q]; if (v > mx) { mx = v; grp = q; } }
            float den = 0.f;
            for (int q = 0; q < 4; ++q) den += expf(lg[q] - mx);
            const float pg = 1.f / den;
            const LAS float* el = lg + 4 + grp * 8;
            int i0 = 0; float l0 = el[0];
            for (int e = 1; e < 8; ++e) { const float v = el[e]; if (v > l0) { l0 = v; i0 = e; } }
            int i1 = (i0 + 1) & 7; float l1 = el[i1];
            for (int e = 0; e < 8; ++e) { const float v = el[e]; if (e != i0 && v > l1) { l1 = v; i1 = e; } }
            const float e1 = expf(l1 - l0), w0 = pg / (1.f + e1), w1 = pg * e1 / (1.f + e1);
            const int id0 = grp * 8 + i0, id1 = grp * 8 + i1;
            beid[(tl * 16 + r) * 2] = id0; beid[(tl * 16 + r) * 2 + 1] = id1;
            int* ti = tokinfo + tok * 8; ti[0] = id0; ti[2] = id1; ((float*)ti)[4] = w0; ((float*)ti)[5] = w1;
        }
    }
    __syncthreads();
    const int ntl = (NT / 16 - tile0) < tpb ? (NT / 16 - tile0) : tpb;
    if (dispatch && F.tid < 32 && ntl > 0) { const int e = F.tid, na = ntl * 32; int c = 0;
        for (int q = 0; q < na; ++q) c += (beid[q] == e) ? 1 : 0;
        if (c > 0) { const int base = (int)__hip_atomic_fetch_add(F.ctl + CW_CNT + e, (unsigned)c, RLX_AGENT); int j = 0;
            for (int q = 0; q < na; ++q) if (beid[q] == e) { const int tok = tile0 * 16 + (q >> 1); lists[e * LIST_CAP + base + j] = tok; tokinfo[tok * 8 + 1 + 2 * (q & 1)] = base + j; ++j; } }
    }
}

__device__ __forceinline__ void router_table_item(unsigned char* ws, const float* wgrp, const float* wer, int f, int lane) {
    const int s = f & 3, nt = (f >> 2) % 3, w = f / 12, i = lane & 15, g = lane >> 4, n = 16 * nt + i; unsigned hi[8], lo[8];
#pragma unroll
    for (int j = 0; j < 8; ++j) { const int k = 128 * w + 32 * s + 8 * g + j; const float v = n < 4 ? wgrp[k * 4 + n] : (n < 36 ? wer[k * 32 + (n - 4)] : 0.f); hi[j] = f2bf(v); lo[j] = f2bf(v - bf2f(hi[j])); }
    v4u ph, pl; ph.x = hi[0] | (hi[1] << 16); ph.y = hi[2] | (hi[3] << 16); ph.z = hi[4] | (hi[5] << 16); ph.w = hi[6] | (hi[7] << 16);
    pl.x = lo[0] | (lo[1] << 16); pl.y = lo[2] | (lo[3] << 16); pl.z = lo[4] | (lo[5] << 16); pl.w = lo[6] | (lo[7] << 16);
    *(GAS v4u*)(ws + WS_RTAB + (size_t)f * 1024 + lane * 16) = ph; *(GAS v4u*)(ws + WS_RTAB + (size_t)(96 + f) * 1024 + lane * 16) = pl;
}
constexpr int FA_T1_OFF = 2048, FA_B2_OFF = FA_T1_OFF + 65536;
constexpr size_t WS_FTAB = WS_WLRU + 640 * 1024;
__device__ __forceinline__ void fourier_table_item(unsigned char* ws, int f, int lane) {
    const int i = lane & 15, g = lane >> 4; unsigned h[8];
    if (f < 64) { const int s = f & 3, p = (f >> 2) & 1, qb = f >> 3, q = 16 * qb + i;
#pragma unroll
        for (int j = 0; j < 8; ++j) { const int k = 32 * s + 8 * g + j, idx = (k * q) & 127; const float ang = (float)idx * (1.f / 64.f); h[j] = f2bf(p == 0 ? cospif(ang) : -sinpif(ang)); } }
    else { const int ff = f - 64, nt = ff & 7, s2 = (ff >> 3) & 1, p = ff >> 4, col = 16 * nt + i, po = col >> 6, cp = col & 63;
#pragma unroll
        for (int j = 0; j < 8; ++j) { const int c = j < 4 ? 32 * s2 + 4 * g + j : 32 * s2 + 16 + 4 * g + (j - 4), idx = (c * cp) & 63; const float ang = (float)idx * (1.f / 32.f);
            const float cs = cospif(ang), sn = sinpif(ang); h[j] = f2bf(p == 0 ? (po == 0 ? cs : -sn) : (po == 0 ? sn : cs)); } }
    v4u w; w.x = h[0] | (h[1] << 16); w.y = h[2] | (h[3] << 16); w.z = h[4] | (h[5] << 16); w.w = h[6] | (h[7] << 16);
    *(GAS v4u*)(ws + WS_FTAB + (size_t)f * 1024 + lane * 16) = w;
}
__device__ __forceinline__ void fourierA_tables(Frame& F) {
    const GAS v4u* src = (const GAS v4u*)(F.ws + WS_FTAB); LAS v4u* dst = (LAS v4u*)(F.lds + FA_T1_OFF);
#pragma unroll
    for (int q = 0; q < 12; ++q) dst[F.tid + q * 512] = src[F.tid + q * 512];
    __syncthreads();
}
__device__ __forceinline__ void fourierA_unit(Frame& F, int b, int r, int gch) {
    const int lane = F.lane, i = lane & 15, g = lane >> 4;
    const bf16* UF = (const bf16*)(F.ws + WS_UF); bf16* Z2 = (bf16*)(F.ws + WS_HX);
    const LAS unsigned char* T1 = F.lds + FA_T1_OFF; const LAS unsigned char* B2 = F.lds + FA_B2_OFF;
    bf16x8 U[4][4];
#pragma unroll
    for (int m = 0; m < 4; ++m)
#pragma unroll
        for (int s = 0; s < 4; ++s) U[m][s] = *(const GAS bf16x8*)(UF + ((size_t)(b * SEQ + r * 64 + 16 * m + i)) * 512 + gch * 128 + 32 * s + 8 * g);
    bf16* zbase = Z2 + ((size_t)((b * 4 + gch) * 32 + r) * 2) * 64 * 128;
    for (int qb = 0; qb < 8; ++qb) {
        f32x4 X[2][4];
#pragma unroll
        for (int p = 0; p < 2; ++p)
#pragma unroll
            for (int m = 0; m < 4; ++m) X[p][m] = (f32x4){0.f, 0.f, 0.f, 0.f};
#pragma unroll
        for (int p = 0; p < 2; ++p)
#pragma unroll
            for (int s = 0; s < 4; ++s) { const bf16x8 tf = *(const LAS bf16x8*)(T1 + (((qb * 2 + p) * 4 + s) * 64 + lane) * 16);
#pragma unroll
                for (int m = 0; m < 4; ++m) X[p][m] = __builtin_amdgcn_mfma_f32_16x16x32_bf16(U[m][s], tf, X[p][m], 0, 0, 0); }
        bf16x8 XA[2][2];
#pragma unroll
        for (int p = 0; p < 2; ++p)
#pragma unroll
            for (int s2 = 0; s2 < 2; ++s2) { const f32x4 lo = X[p][2 * s2], hi = X[p][2 * s2 + 1]; v4u w;
                w.x = pg8::cvt_pk_bf16(lo[0], lo[1]); w.y = pg8::cvt_pk_bf16(lo[2], lo[3]); w.z = pg8::cvt_pk_bf16(hi[0], hi[1]); w.w = pg8::cvt_pk_bf16(hi[2], hi[3]);
                XA[p][s2] = __builtin_bit_cast(bf16x8, w); }
        f32x4 D2[8];
#pragma unroll
        for (int nt = 0; nt < 8; ++nt) D2[nt] = (f32x4){0.f, 0.f, 0.f, 0.f};
#pragma unroll
        for (int p = 0; p < 2; ++p)
#pragma unroll
            for (int s2 = 0; s2 < 2; ++s2)
#pragma unroll
                for (int nt = 0; nt < 8; ++nt) { const bf16x8 bfr = *(const LAS bf16x8*)(B2 + ((((p * 2 + s2) * 8 + nt) * 64) + lane) * 16);
                    D2[nt] = __builtin_amdgcn_mfma_f32_16x16x32_bf16(XA[p][s2], bfr, D2[nt], 0, 0, 0); }
#pragma unroll
        for (int nt = 0; nt < 8; ++nt) { const int col = 16 * nt + i; v2u w; w.x = pg8::cvt_pk_bf16(D2[nt][0], D2[nt][1]); w.y = pg8::cvt_pk_bf16(D2[nt][2], D2[nt][3]);
            *(GAS v2u*)(zbase + (size_t)col * 128 + 16 * qb + 4 * g) = w; }
    }
}
constexpr int FB_STRIDE = 272;
__device__ __forceinline__ void fourierB_unit(Frame& F, int b, int gch, int cp, const bf16x8 (&TW)[2][2]) {
    const int lane = F.lane, i = lane & 15, g = lane >> 4;
    const bf16* Z2 = (const bf16*)(F.ws + WS_HX); bf16* Fo = (bf16*)(F.ws + WS_UF);
    LAS unsigned char* tile = F.lds + F.wave * (64 * FB_STRIDE);
#pragma unroll 4
    for (int it = 0; it < 16; ++it) { const int k = it * 4 + (lane >> 4), part = k >> 5, r = k & 31;
        const v4u v = *(const GAS v4u*)(Z2 + ((size_t)(((b * 4 + gch) * 32 + r) * 2 + part) * 64 + cp) * 128 + 8 * (lane & 15));
        *(LAS v4u*)(tile + k * FB_STRIDE + 16 * (lane & 15)) = v; }
    LDS_WAIT(); asm volatile("" ::: "memory");
    f32x4 acc[8][2];
#pragma unroll
    for (int mt = 0; mt < 8; ++mt) { acc[mt][0] = (f32x4){0.f, 0.f, 0.f, 0.f}; acc[mt][1] = (f32x4){0.f, 0.f, 0.f, 0.f}; }
    const unsigned tbase = (unsigned)(size_t)tile + (unsigned)(((lane & 15) >> 2) * FB_STRIDE + 8 * (lane & 3));
#pragma unroll
    for (int mt = 0; mt < 8; ++mt)
#pragma unroll
        for (int s = 0; s < 2; ++s) { v2u t0, t1;
            const unsigned a0 = tbase + (unsigned)((32 * s + 8 * g) * FB_STRIDE + 32 * mt), a1 = a0 + 4 * FB_STRIDE;
            asm volatile("ds_read_b64_tr_b16 %0, %2\n\tds_read_b64_tr_b16 %1, %3\n\ts_waitcnt lgkmcnt(0)" : "=&v"(t0), "=&v"(t1) : "v"(a0), "v"(a1) : "memory");
            v4u w; w.x = t0.x; w.y = t0.y; w.z = t1.x; w.w = t1.y; const bf16x8 af = __builtin_bit_cast(bf16x8, w);
            acc[mt][0] = __builtin_amdgcn_mfma_f32_16x16x32_bf16(af, TW[s][0], acc[mt][0], 0, 0, 0);
            acc[mt][1] = __builtin_amdgcn_mfma_f32_16x16x32_bf16(af, TW[s][1], acc[mt][1], 0, 0, 0); }
#pragma unroll
    for (int mt = 0; mt < 8; ++mt)
#pragma unroll
        for (int nt = 0; nt < 2; ++nt) { const int rp = 16 * nt + i; const f32x4 v = acc[mt][nt] * (1.f / 512.f); v2u w; w.x = pg8::cvt_pk_bf16(v[0], v[1]); w.y = pg8::cvt_pk_bf16(v[2], v[3]);
            *(GAS v2u*)(Fo + ((size_t)(b * SEQ + rp * 64 + cp)) * 512 + gch * 128 + 16 * mt + 4 * g) = w; }
    asm volatile("" ::: "memory");
}
__device__ __forceinline__ void fourierB_twiddles(int lane, bf16x8 (&TW)[2][2]) {
    const int i = lane & 15, g = lane >> 4;
#pragma unroll
    for (int s = 0; s < 2; ++s)
#pragma unroll
        for (int nt = 0; nt < 2; ++nt) { unsigned h[8];
#pragma unroll
            for (int j = 0; j < 8; ++j) { const int r = 8 * g + j, rp = 16 * nt + i, idx = (r * rp) & 31; const float ang = (float)idx * (1.f / 16.f);
                h[j] = f2bf(s == 0 ? cospif(ang) : sinpif(ang)); }
            v4u w; w.x = h[0] | (h[1] << 16); w.y = h[2] | (h[3] << 16); w.z = h[4] | (h[5] << 16); w.w = h[6] | (h[7] << 16); TW[s][nt] = __builtin_bit_cast(bf16x8, w); }
}
constexpr int LRU_STRIDE = 144;
constexpr int LRU_WAVE_BYTES = 2 * 64 * LRU_STRIDE;
constexpr int SUM_CHUNKS = 48;
constexpr size_t WS_LRUC = WS_WLRU + 512 * 1024;
__device__ __forceinline__ size_t sum_index(int b, int chunk, int dir, int ch) { return ((((size_t)b * SUM_CHUNKS + chunk) * 2 + dir) * 512 + ch) * 2; }

__device__ __forceinline__ void lru_carry(const float* SUM, int b, int lc, int ch, float& Hf, float& Hb) {
    float H = 0.f;
#pragma unroll 8
    for (int c = 0; c < lc; ++c) { const f32x2 v = *(const f32x2*)(SUM + sum_index(b, c, 0, ch)); H = v.x * H + v.y; }
    Hf = H; H = 0.f;
#pragma unroll 8
    for (int c = 15; c >= 0; --c) { const f32x2 v = *(const f32x2*)(SUM + sum_index(b, c, 1, ch)); H = v.x * H + v.y; }
#pragma unroll 8
    for (int c = SUM_CHUNKS - 1; c > lc; --c) { const f32x2 v = *(const f32x2*)(SUM + sum_index(b, c, 1, ch)); H = v.x * H + v.y; }
    Hb = H;
}

template <int MT, int PASS>
__device__ __forceinline__ void lru_unit(Frame& F, const Args& a, int b, int seqbase, int Lseq, int pos0, int h, int sumchunk, float HinF, float HinB) {
    constexpr int L = 16 * MT, NG = 64 / L, CPG = 8 / NG, NTOK = 4 * MT;
    const int lane = F.lane, i16 = lane & 15, g = lane >> 4;
    const bf16* UR = (const bf16*)(F.ws + WS_UR); const bf16* GY = (const bf16*)(F.ws + WS_GY); bf16* R = (bf16*)(F.ws + WS_R);
    const bf16* WL = (const bf16*)(F.ws + WS_WLRU); float* SUM = (float*)(F.ws + WS_LRUSUM); const f32x4* LC = (const f32x4*)(F.ws + WS_LRUC);
    const float* convw = a.in[8]; const float* convb = a.in[9];
    LAS unsigned char* xt = F.lds + F.wave * LRU_WAVE_BYTES; LAS unsigned char* gt = xt + 64 * LRU_STRIDE;
    bf16x8 Bn[4];
#define LRU_LOADB(dst, ct_, dir_) do { _Pragma("unroll") for (int _ty = 0; _ty < 2; ++_ty) _Pragma("unroll") for (int _s = 0; _s < 2; ++_s) \
        dst[_ty * 2 + _s] = *(const GAS bf16x8*)(WL + (size_t)(((((h * 2 + (dir_)) * 2 + _ty) * 4 + (ct_)) * 2 + _s)) * 512 + lane * 8); } while (0)
    LRU_LOADB(Bn, 0, 0);
    {
        const int t = lane % L, grp = lane / L, p = pos0 + t;
#pragma unroll
        for (int q = 0; q < CPG; ++q) { const int cc = grp * CPG + q, ch0 = h * 64 + 8 * cc; float s[8];
#pragma unroll
            for (int j = 0; j < 8; ++j) s[j] = convb[ch0 + j];
#pragma unroll
            for (int k = 0; k < 4; ++k) { const int pp = p + k - 2;
                if (pp >= 0 && pp < Lseq) { const v4u u = *(const GAS v4u*)(UR + (size_t)(seqbase + pp) * 512 + ch0); const float* w = convw + k * 512 + ch0;
                    s[0] += w[0] * bf2f(u.x & 0xffffu); s[1] += w[1] * bf2f(u.x >> 16); s[2] += w[2] * bf2f(u.y & 0xffffu); s[3] += w[3] * bf2f(u.y >> 16);
                    s[4] += w[4] * bf2f(u.z & 0xffffu); s[5] += w[5] * bf2f(u.z >> 16); s[6] += w[6] * bf2f(u.w & 0xffffu); s[7] += w[7] * bf2f(u.w >> 16); } }
            v4u o; o.x = pk2(s[0], s[1]); o.y = pk2(s[2], s[3]); o.z = pk2(s[4], s[5]); o.w = pk2(s[6], s[7]);
            *(LAS v4u*)(xt + t * LRU_STRIDE + 16 * cc) = o;
            if (PASS == 2) *(LAS v4u*)(gt + t * LRU_STRIDE + 16 * cc) = *(const GAS v4u*)(GY + (size_t)(seqbase + p) * 512 + ch0); }
    }
    LDS_WAIT(); asm volatile("" ::: "memory");
    bf16x8 Af[MT][2];
    const int tokA = NTOK * (i16 >> 2) + (i16 & 3);
#pragma unroll
    for (int m = 0; m < MT; ++m)
#pragma unroll
        for (int s = 0; s < 2; ++s) Af[m][s] = *(const LAS bf16x8*)(xt + (tokA + 4 * m) * LRU_STRIDE + (32 * s + 8 * g) * 2);
    const int tokD = NTOK * g;
#pragma unroll 1
    for (int ct = 0; ct < 4; ++ct) {
        const int ch = h * 64 + 16 * ct + i16;
        float xcv[NTOK], gyv[NTOK], hf[NTOK];
#pragma unroll
        for (int n = 0; n < NTOK; ++n) { xcv[n] = bf2f((unsigned)*(const LAS unsigned short*)(xt + (tokD + n) * LRU_STRIDE + (16 * ct + i16) * 2));
            if (PASS == 2) gyv[n] = bf2f((unsigned)*(const LAS unsigned short*)(gt + (tokD + n) * LRU_STRIDE + (16 * ct + i16) * 2)); }
#pragma unroll
        for (int dir = 0; dir < 2; ++dir) {
            bf16x8 Bc[4];
#pragma unroll
            for (int q = 0; q < 4; ++q) Bc[q] = Bn[q];
            if (dir == 0) LRU_LOADB(Bn, ct, 1); else LRU_LOADB(Bn, (ct + 1) & 3, 0);
            const f32x4 lc = LC[dir * 512 + ch];
            f32x4 ca[MT], cx[MT];
#pragma unroll
            for (int m = 0; m < MT; ++m) { ca[m] = (f32x4){lc.x, lc.x, lc.x, lc.x}; cx[m] = (f32x4){lc.y, lc.y, lc.y, lc.y}; }
#pragma unroll
            for (int s = 0; s < 2; ++s)
#pragma unroll
                for (int m = 0; m < MT; ++m) { ca[m] = __builtin_amdgcn_mfma_f32_16x16x32_bf16(Af[m][s], Bc[s], ca[m], 0, 0, 0); cx[m] = __builtin_amdgcn_mfma_f32_16x16x32_bf16(Af[m][s], Bc[2 + s], cx[m], 0, 0, 0); }
            float Av[NTOK], Bv[NTOK];
#pragma unroll
            for (int m = 0; m < MT; ++m)
#pragma unroll
                for (int q = 0; q < 4; q += 2) { const int n = 4 * m + q;
                    f32x2 ea, ex; ea.x = __builtin_amdgcn_exp2f(ca[m][q]); ea.y = __builtin_amdgcn_exp2f(ca[m][q + 1]); ex.x = __builtin_amdgcn_exp2f(cx[m][q]); ex.y = __builtin_amdgcn_exp2f(cx[m][q + 1]);
                    ea = ea + 1.f; ex = ex + 1.f;
                    const f32x2 den = ea * ex; f32x2 rc; rc.x = __builtin_amdgcn_rcpf(den.x); rc.y = __builtin_amdgcn_rcpf(den.y);
                    const f32x2 r = ex * rc, ig = ea * rc;
                    const f32x2 z = r * lc.z;
                    f32x2 av = z * (1.f / 24.f) + (-1.f / 6.f); av = av * z + 0.5f; av = av * z + (-1.f); av = av * z + 1.f;
                    const f32x2 om = 1.f - av * av;
                    f32x2 mu; mu.x = __builtin_amdgcn_sqrtf(__builtin_fabsf(om.x)); mu.y = __builtin_amdgcn_sqrtf(__builtin_fabsf(om.y));
                    const f32x2 xv = {xcv[n], xcv[n + 1]}; const f32x2 bb = mu * ig * xv;
                    Av[n] = av.x; Av[n + 1] = av.y; Bv[n] = bb.x; Bv[n + 1] = bb.y; }
            float P = 1.f, H = 0.f;
#pragma unroll
            for (int n = 0; n < NTOK; ++n) { const int nn = dir == 0 ? n : NTOK - 1 - n; H = Av[nn] * H + Bv[nn]; P *= Av[nn]; }
            float Pj[4], Hj[4];
#pragma unroll
            for (int j = 0; j < 4; ++j) { Pj[j] = __shfl(P, i16 + 16 * j); Hj[j] = __shfl(H, i16 + 16 * j); }
            if (PASS == 1) {
                float Pt = 1.f, Ht = 0.f;
#pragma unroll
                for (int j = 0; j < 4; ++j) { const int jj = dir == 0 ? j : 3 - j; Ht = Pj[jj] * Ht + Hj[jj]; Pt *= Pj[jj]; }
                if (g == 0) *(f32x2*)(SUM + sum_index(b, sumchunk, dir, ch)) = (f32x2){Pt, Ht};
            } else {
                float C = __shfl(dir == 0 ? HinF : HinB, 16 * ct + i16);
#pragma unroll
                for (int j = 0; j < 4; ++j) { const int jj = dir == 0 ? j : 3 - j; const bool before = dir == 0 ? (jj < g) : (jj > g); if (before) C = Pj[jj] * C + Hj[jj]; }
                float hh = C;
#pragma unroll
                for (int n = 0; n < NTOK; ++n) { const int nn = dir == 0 ? n : NTOK - 1 - n; hh = Av[nn] * hh + Bv[nn];
                    if (dir == 0) hf[nn] = hh;
                    else *(LAS unsigned short*)(xt + (tokD + nn) * LRU_STRIDE + (16 * ct + i16) * 2) = (unsigned short)f2bf((hf[nn] + hh) * gyv[nn]); }
            }
        }
    }
#undef LRU_LOADB
    if (PASS == 2) {
        LDS_WAIT(); asm volatile("" ::: "memory");
        const int t = lane % L, grp = lane / L, p = pos0 + t;
#pragma unroll
        for (int q = 0; q < CPG; ++q) { const int cc = grp * CPG + q;
            *(GAS v4u*)(R + (size_t)(seqbase + p) * 512 + h * 64 + 8 * cc) = *(const LAS v4u*)(xt + t * LRU_STRIDE + 16 * cc); }
        LDS_WAIT(); asm volatile("" ::: "memory");
    }
}
#ifndef PROBE_LO
#define PROBE_LO 0
#define PROBE_HI 0
#endif
#ifndef PROBE_BEFORE
#define PROBE_BEFORE 0
#endif
#ifndef PROBE_PAD
#define PROBE_PAD 3
#endif
__device__ __forceinline__ void ph2(Frame& F, const Args& args) {
    ProjSched S{(const char*)(F.ws + WS_HX), (const char*)(F.ws + WS_WIN), F.G, (int)blockIdx.x};
    EpiProj E{F.ws};
    pg8::gemm_phase<EpiProj, ProjSched, true, true, false>(F.lds, 1024, S, E);
}
__device__ __forceinline__ void ph3(Frame& F, const Args& args) {
    const int gw = F.vcu * NWAVES + F.wave, NGW = F.G * NWAVES;
    STAMP(F, 30);
    if (args.pad & 1) { fourierA_tables(F);
    for (int uid = gw; uid < 2048; uid += NGW) fourierA_unit(F, uid >> 7, (uid >> 2) & 31, uid & 3);
    __syncthreads(); }
    STAMP(F, 31);
    if (args.pad & 2) {
    LAS float* scr = (LAS float*)(F.lds + F.wave * LRU_WAVE_BYTES);
    constexpr int TR_REST = T_ALL - T_P0;
    int nu = 0;
    for (int uid = gw; uid < 4096; uid += NGW, ++nu) { const int h = uid & 7, j = (uid >> 3) & 31, b = uid >> 8;
        const int lo_ = (TR_REST / 2) * nu, hi_ = nu == 0 ? TR_REST / 2 : TR_REST;
        if (F.wave >= 4) tr_run(args, F.ws, T_P0 + lo_ + gw, NGW, T_P0 + hi_, F.lane, scr);
        lru_unit<4, 1>(F, args, b, b * SEQ, SEQ, 64 * j, h, 16 + j, 0.f, 0.f);
        if (F.wave < 4) tr_run(args, F.ws, T_P0 + lo_ + gw, NGW, T_P0 + hi_, F.lane, scr); }
    STAMP(F, 32);
    for (int uid = gw; uid < 2048; uid += NGW) { const int h = uid & 7, j = (uid >> 3) & 15, b = uid >> 7; lru_unit<1, 1>(F, args, b, NT + b * CTX, CTX, 16 * j, h, j, 0.f, 0.f); } }
    STAMP(F, 33);
}
__device__ __forceinline__ void ph4(Frame& F, const Args& args) {
    const int gw = F.vcu * NWAVES + F.wave, NGW = F.G * NWAVES;
    STAMP(F, 40);
    float cF[2] = {0.f, 0.f}, cB[2] = {0.f, 0.f};
    if (args.pad & 2) {
#pragma unroll
    for (int k = 0; k < 2; ++k) { const int uid = gw + k * NGW; if (uid < 4096) lru_carry((const float*)(F.ws + WS_LRUSUM), uid >> 8, 16 + ((uid >> 3) & 31), (uid & 7) * 64 + F.lane, cF[k], cB[k]); } }
    STAMP(F, 41);
    if (args.pad & 1) { bf16x8 TW[2][2]; fourierB_twiddles(F.lane, TW);
      for (int uid = gw; uid < 4096; uid += NGW) fourierB_unit(F, uid >> 8, (uid >> 6) & 3, uid & 63, TW); }
    __syncthreads();
    STAMP(F, 42);
    if (args.pad & 2) {
#pragma unroll
    for (int k = 0; k < 2; ++k) { const int uid = gw + k * NGW; if (uid < 4096) { const int h = uid & 7, j = (uid >> 3) & 31, b = uid >> 8; lru_unit<4, 2>(F, args, b, b * SEQ, SEQ, 64 * j, h, 16 + j, cF[k], cB[k]); } } }
    STAMP(F, 43);
}
__device__ __forceinline__ void ph5(Frame& F, const Args& args) {
    PairSched S{(const char*)(F.ws + WS_UF), (const char*)(F.ws + WS_WFO), (const char*)(F.ws + WS_R), (const char*)(F.ws + WS_WLO), F.G, (int)blockIdx.x};
    EpiMerge E{(const bf16*)(F.ws + WS_GF), (const bf16*)(F.ws + WS_GR), (bf16*)(F.ws + WS_HX)};
    pg8::gemm_phase<EpiMerge, PairSched, true, true, false>(F.lds, 512, S, E);
}
__device__ __forceinline__ void ph7(Frame& F, const Args& args) {
    PlainSched S{(const char*)(F.ws + WS_HX), (const char*)(F.ws + WS_WOUT), 128, 4, 1024, F.G, (int)blockIdx.x};
    EpiOut E{args.in[0], (const float*)(F.ws + WS_MOD), args.out};
    pg8::gemm_phase<EpiOut, PlainSched, true, true, false>(F.lds, 1024, S, E);
}
__device__ __forceinline__ void ph9(Frame& F, const Args& args) {
    moe_tables(F);
    MoeSched<true> S{F.MISC + 64, (const unsigned*)(F.ctl + CW_CNT), (const char*)(F.ws + WS_T), (const int*)(F.ws + WS_LISTS), nullptr, (const char*)(F.ws + WS_WGU), F.G, (int)blockIdx.x};
    EpiMoe1 E{(bf16*)(F.ws + WS_H)};
    pg8::gemm_phase<EpiMoe1, MoeSched<true>, true, true, true>(F.lds, 1024, S, E);
}
__device__ __forceinline__ void ph10(Frame& F, const Args& args) {
    moe_tables(F);
    MoeSched<false> S{F.MISC + 64, (const unsigned*)(F.ctl + CW_CNT), nullptr, nullptr, (const char*)(F.ws + WS_H), (const char*)(F.ws + WS_WD), F.G, (int)blockIdx.x};
    EpiY E{(bf16*)(F.ws + WS_Y)};
    pg8::gemm_phase<EpiY, MoeSched<false>, true, true, false>(F.lds, 512, S, E);
}
#ifndef PROBE_K
#define PROBE_K 4
#endif
#ifndef PROBE_REP
#define PROBE_REP -1
#endif
__global__ void __launch_bounds__(NWAVES * 64, 2) mk_fwd(Args args) {
    extern __shared__ __attribute__((aligned(16))) unsigned char lds[];
    Frame F;
    F.lds = (LAS unsigned char*)lds; F.MISC = (volatile LAS unsigned*)(F.lds + MISC_OFF);
    F.tid = threadIdx.x; F.lane = F.tid & 63; F.wave = __builtin_amdgcn_readfirstlane(F.tid >> 6);
    F.G = gridDim.x; { const int bx = blockIdx.x; F.vcu = (F.G % 8 == 0) ? (bx % 8) * (F.G / 8) + bx / 8 : bx; }
    F.ws = args.ws; F.ctl = (gu32*)(args.ws + WS_CTL);
    if (F.tid < 64) F.MISC[F.tid] = 0u;
    __syncthreads();
    XcdBarrier bar; bar.bar = (unsigned*)(F.ctl + CW_BAR); bar.x = 0; bar.st = nullptr;
    if (args.use_bar) bar = xcd_barrier_post((unsigned*)(F.ctl + CW_BAR), F.MISC + 8);
    F.tp0 = 0; F.tp1 = 0;
    const int lo = args.ph_lo, hi = args.ph_hi;
#define IN(k) (lo <= (k) && (k) < hi)
#define SEAM(k) do { if (IN(k) && IN((k) + 1)) xcd_barrier(bar); } while (0)
#ifndef PROBE_MASK
#define PROBE_MASK 3
#endif
#define PHASE(k, call) do { STAMP(F, k); if (IN(k)) { call; if (PROBE_REP == (k)) { xcd_barrier(bar); Args a2 = args; a2.pad = PROBE_MASK; { const Args& args = a2; call; } } } SEAM(k); } while (0)
    PHASE(0, p0_prologue(F, args));
    PHASE(1, p1_normmod(F, args));
    if (PROBE_REP == 100) { for (int q = 0; q < 10; ++q) xcd_barrier(bar); }
    PHASE(2, ph2(F, args));
    PHASE(3, ph3(F, args));
    PHASE(4, ph4(F, args));
    PHASE(5, ph5(F, args));
    PHASE(7, ph7(F, args));
    PHASE(8, p8_route(F, args));
    PHASE(9, ph9(F, args));
    PHASE(10, ph10(F, args));
    STAMP(F, 11);
    if (IN(11)) { moe_tables(F); if (PROBE_REP == 11) { p_final(F, args, (float*)(F.ws + WS_HX)); xcd_barrier(bar); } p_final(F, args, args.out); }
    STAMP(F, 12);
    if (PROBE_A >= 0) { if (blockIdx.x == 0 && F.tid == 0 && F.tp1 > F.tp0) { const unsigned long long d = (F.tp1 - F.tp0) * PROBE_K, t0 = __builtin_amdgcn_s_memrealtime(); while (__builtin_amdgcn_s_memrealtime() - t0 < d) __builtin_amdgcn_s_sleep(8); } }
#undef IN
#undef SEAM
#undef PHASE
}

extern "C" void kernel_launch(void* const* d_in, const int* in_sizes, int n_in, void* d_out, int out_size, void* d_ws, size_t ws_size, hipStream_t stream) {
    static int grid = 0;
    if (grid == 0) {
        if (n_in != 27 || ws_size < WS_END || out_size != NT * D) { fprintf(stderr, "kernel_launch: unexpected sizes n_in %d ws %zu out %d\n", n_in, ws_size, out_size); grid = -1; return; }
        int dev = 0, cus = 0;
        if (hipGetDevice(&dev) != hipSuccess || hipDeviceGetAttribute(&cus, hipDeviceAttributeMultiprocessorCount, dev) != hipSuccess) { grid = -1; return; }
        if (hipFuncSetAttribute((const void*)mk_fwd, hipFuncAttributeMaxDynamicSharedMemorySize, LDS_BYTES) != hipSuccess) { fprintf(stderr, "kernel_launch: hipFuncSetAttribute failed\n"); grid = -1; return; }
        int per_cu = 0;
        if (hipOccupancyMaxActiveBlocksPerMultiprocessor(&per_cu, (const void*)mk_fwd, NWAVES * 64, LDS_BYTES) != hipSuccess || per_cu < 1) { fprintf(stderr, "kernel_launch: occupancy query says %d\n", per_cu); }
        (void)hipGetLastError();
        grid = cus;
    }
    if (grid < 0) return;
    (void)hipMemsetAsync((char*)d_ws + WS_CTL, 0, CTL_ZERO_BYTES, stream);
    Args a{};
    for (int i = 0; i < 27; ++i) a.in[i] = (const float*)d_in[i];
    a.out = (float*)d_out; a.ws = (unsigned char*)d_ws; a.pad = 3;
#if PROBE_BEFORE
    a.use_bar = 0; a.pad = 0; a.ph_lo = 3; a.ph_hi = 4; hipLaunchKernelGGL(mk_fwd, dim3(grid), dim3(NWAVES * 64), LDS_BYTES, stream, a); a.pad = 3;
#endif
    a.use_bar = 1; a.ph_lo = 0; a.ph_hi = 12;
    hipLaunchKernelGGL(mk_fwd, dim3(grid), dim3(NWAVES * 64), LDS_BYTES, stream, a);
#if PROBE_HI > PROBE_LO
    a.use_bar = 0; a.out = (float*)((char*)d_ws + 124 * MiB); a.pad = PROBE_PAD;
    for (int ph = PROBE_LO; ph < PROBE_HI; ++ph) { a.ph_lo = ph; a.ph_hi = ph + 1; hipLaunchKernelGGL(mk_fwd, dim3(grid), dim3(NWAVES * 64), LDS_BYTES, stream, a); }
#endif
}
```

```cpp
#include <hip/hip_runtime.h>
#include <cstdio>
#include <cstdint>

constexpr int D = 1024, NB = 16, SEQ = 2048, CTX = 256;
constexpr int NT = NB * SEQ;
constexpr int NC = NB * CTX;
constexpr int NTC = NT + NC;
constexpr int DIN = 3584;
constexpr int NE = 32, DE = 512;
constexpr float EPS = 1e-6f;
constexpr int NWAVES = 8;
constexpr int SLOT_ROWS = 65536 + 8192;
constexpr int LIST_CAP = 32768;

constexpr size_t MiB = 1u << 20;
constexpr size_t WS_CTL = 0, CTL_ZERO_BYTES = 1 * MiB;
constexpr size_t WS_MOD = 1 * MiB;
constexpr size_t WS_TOKINFO = 2 * MiB;
constexpr size_t WS_LISTS = 4 * MiB;
constexpr size_t WS_LRUSUM = 8 * MiB;
constexpr size_t WS_WIN = 16 * MiB;
constexpr size_t WS_WFO = 23 * MiB;
constexpr size_t WS_WLO = 24 * MiB;
constexpr size_t WS_WOUT = 25 * MiB;
constexpr size_t WS_WLRU = 27 * MiB;
constexpr size_t WS_WGU = 28 * MiB;
constexpr size_t WS_WD = 92 * MiB;
constexpr size_t WS_HX = 124 * MiB;
constexpr size_t WS_UF = 196 * MiB;
constexpr size_t WS_UR = 228 * MiB;
constexpr size_t WS_GY = 264 * MiB;
constexpr size_t WS_P1 = 228 * MiB;
constexpr size_t WS_GF = 296 * MiB;
constexpr size_t WS_GR = 360 * MiB;
constexpr size_t WS_R = 424 * MiB;
constexpr size_t WS_T = 196 * MiB;
constexpr size_t WS_H = 260 * MiB;
constexpr size_t WS_Y = 332 * MiB;
constexpr size_t WS_END = 512 * MiB;
constexpr int CW_TMO = 0, CW_CODE = 1;
constexpr int CW_CNT = 64;
constexpr int CW_BAR = 4096;

constexpr int LDS_BYTES = 155648;
constexpr int RING_BYTES = 131072;
constexpr int MISC_OFF = 155648 - 1024;

#define GAS __attribute__((address_space(1)))
#define LAS __attribute__((address_space(3)))
typedef unsigned short bf16;
typedef unsigned v4u __attribute__((ext_vector_type(4)));
typedef unsigned v2u __attribute__((ext_vector_type(2)));
typedef float f32x4 __attribute__((ext_vector_type(4)));
typedef float f32x2 __attribute__((ext_vector_type(2)));
typedef short bf16x8 __attribute__((ext_vector_type(8)));
typedef GAS unsigned gu32;
#define RLX_AGENT __ATOMIC_RELAXED, __HIP_MEMORY_SCOPE_AGENT
#define LDS_WAIT() asm volatile("s_waitcnt lgkmcnt(0)" ::: "memory")
#define VM_WAIT() asm volatile("s_waitcnt vmcnt(0)" ::: "memory")
__device__ __forceinline__ unsigned f2bf(float f) { unsigned u = __builtin_bit_cast(unsigned, f); return (u + 0x7fffu + ((u >> 16) & 1u)) >> 16; }
typedef __bf16 bf16x2_t __attribute__((ext_vector_type(2)));
__device__ __forceinline__ unsigned pk2(float lo, float hi) { const f32x2 v = {lo, hi}; return __builtin_bit_cast(unsigned, __builtin_convertvector(v, bf16x2_t)); }
__device__ __forceinline__ float bf2f(unsigned b) { return __builtin_bit_cast(float, b << 16); }
__device__ __forceinline__ float fast_sigmoid(float v) { return __builtin_amdgcn_rcpf(1.f + __builtin_amdgcn_exp2f(-1.4426950409f * v)); }
__device__ __forceinline__ float fast_gelu_tanh(float v) { const float u = 1.5957691216f * (v + 0.044715f * v * v * v); return v * fast_sigmoid(u); }
__device__ __forceinline__ float fast_silu(float v) { return v * fast_sigmoid(v); }
__device__ __forceinline__ float wave_sum(float v) {
#pragma unroll
    for (int o = 1; o < 64; o <<= 1) v += __shfl_xor(v, o);
    return v;
}
namespace pg8 {
#define PG8_LAS __attribute__((address_space(3)))
typedef unsigned short bf16_t;
typedef unsigned u32x4 __attribute__((ext_vector_type(4)));
constexpr int BM = 256, BK = 64, HALF = 128, HTB = HALF * BK * 2  , STAGE_BYTES = 8 * HTB, NXCD = 8, WGM = 8;

__host__ __device__ __forceinline__ int lds_byte(int r, int c) { const int st = (r >> 4) * 2 + (c >> 5), rr = r & 15, cc = c & 31, ob = rr * 64 + cc * 2; return st * 1024 + (ob ^ (((ob >> 9) & 1) << 5)); }
__host__ __device__ __forceinline__ void stage_rc(int b, int& R, int& C) { const int st = b / 1024, sb = b % 1024, swz = sb ^ (((sb >> 9) & 1) << 5); R = (st >> 1) * 16 + swz / 64; C = (st & 1) * 32 + (swz % 64) / 2; }
__host__ __device__ __forceinline__ int perm32(int rho) { const int n = rho >> 4, i = rho & 15; return 8 * (i >> 2) + 4 * n + (i & 3); }

struct Unit { int pm, pn; const char* a; const char* b; const int* rows; int nrows; int aux; };

__host__ __device__ __forceinline__ void static_tile(int L, int nM, int nN, int& pm, int& pn) {
    const int nwg = nM * nN; int wgid = L; { const int q = nwg / NXCD, r = nwg % NXCD, xcd = wgid % NXCD, off = wgid / NXCD; wgid = (xcd < r ? xcd * (q + 1) : r * (q + 1) + (xcd - r) * q) + off; }
    const int nig = WGM * nN, gid = wgid / nig, fm = gid * WGM, gsz = (nM - fm) < WGM ? (nM - fm) : WGM;
    pm = fm + ((wgid % nig) % gsz); pn = (wgid % nig) / gsz;
}

__device__ __forceinline__ unsigned cvt_pk_bf16(float lo, float hi) { return pk2(lo, hi); }

template <class Epi, class Sched, bool ALIGN_EPI, bool SP2, bool GATHER>
__device__ __forceinline__ void gemm_phase(PG8_LAS unsigned char* lds, const int K, const Sched& S, const Epi& E) {
    const int tid = threadIdx.x, wid = __builtin_amdgcn_readfirstlane(tid >> 6), lane = tid & 63, wr = wid >> 2, wc = wid & 3, fr = lane & 15, fq = lane >> 4;
    const int nt = K / BK;
    unsigned voffA[2], voffB[2];
#pragma unroll
    for (int i = 0; i < 2; ++i) { int R, C; stage_rc(tid * 16 + i * 8192, R, C); const int Rb = Epi::PERM ? ((R & ~31) + perm32(R & 31)) : R;
        voffA[i] = (unsigned)(R * K + C) * 2u; voffB[i] = (unsigned)(Rb * K + C) * 2u; }
    unsigned gA[2][2];
    const size_t kstep = (size_t)(BK * 2);
    const size_t hstep = (size_t)HALF * K * 2;
    const unsigned ldsw = (unsigned)wid * 1024u;
    const int aoff = lds_byte(wr * 64 + fr, fq * 8), boff = lds_byte(wc * 32 + fr, fq * 8);
#define PG8_SA(b, h) (((b) * 2 + (h)) * HTB)
#define PG8_SB(b, h) ((4 + (b) * 2 + (h)) * HTB)
#define PG8_STAGE(bufoff, gbase, voff) do { _Pragma("unroll") for (int _i = 0; _i < 2; ++_i) \
        __builtin_amdgcn_global_load_lds((const unsigned*)((const char*)(gbase) + (voff)[_i]), (PG8_LAS unsigned*)(lds + (bufoff) + ldsw + _i * 8192), 16, 0, 0); } while (0)
#define PG8_STAGE_A(bufoff, kptr, h, NX) do { if constexpr (GATHER) { PG8_STAGE(bufoff, kptr, gA[h]); } else PG8_STAGE(bufoff, (kptr) + (h) * hstep, voffA); } while (0)
#define PG8_LDA(dst, b, h) do { _Pragma("unroll") for (int m = 0; m < 4; ++m) _Pragma("unroll") for (int k = 0; k < 2; ++k) dst[m][k] = *(const PG8_LAS bf16x8*)(lds + PG8_SA(b, h) + aoff + m * 2048 + k * 1024); } while (0)
#define PG8_LDB(dst, b, h) do { _Pragma("unroll") for (int n = 0; n < 2; ++n) _Pragma("unroll") for (int k = 0; k < 2; ++k) dst[n][k] = *(const PG8_LAS bf16x8*)(lds + PG8_SB(b, h) + boff + n * 2048 + k * 1024); } while (0)
#define PG8_MMA(ai, bj, At, Bt) do { __builtin_amdgcn_s_setprio(1); _Pragma("unroll") for (int m = 0; m < 4; ++m) _Pragma("unroll") for (int n = 0; n < 2; ++n) _Pragma("unroll") for (int k = 0; k < 2; ++k) \
        acc[ai][bj][m][n] = __builtin_amdgcn_mfma_f32_16x16x32_bf16(Bt[n][k], At[m][k], acc[ai][bj][m][n], 0, 0, 0); __builtin_amdgcn_s_setprio(0); } while (0)
#define PG8_WAIT_V(n) asm volatile("s_waitcnt vmcnt(" #n ")" ::: "memory")
#define PG8_WAIT_L(n) asm volatile("s_waitcnt lgkmcnt(" #n ")" ::: "memory")
#define PG8_BAR __builtin_amdgcn_s_barrier()
#define PG8_SCHED __builtin_amdgcn_sched_barrier(0)
#define PG8_GOFF(dst, u) do { if constexpr (GATHER) { _Pragma("unroll") for (int _i = 0; _i < 2; ++_i) { int _R, _C; stage_rc(tid * 16 + _i * 8192, _R, _C); \
        _Pragma("unroll") for (int _h = 0; _h < 2; ++_h) { const int _r = _h * HALF + _R; const int _t = _r < (u).nrows ? (u).rows[_r] : 0; dst[_h][_i] = (unsigned)(_t * K + _C) * 2u; } } } } while (0)
    Unit cur, nxt; int ui = 0;
    if (!S.next(0, cur)) return;
    f32x4 acc[2][2][4][2];
#pragma unroll
    for (int a = 0; a < 2; ++a)
#pragma unroll
        for (int b = 0; b < 2; ++b)
#pragma unroll
            for (int m = 0; m < 4; ++m)
#pragma unroll
                for (int n = 0; n < 2; ++n) acc[a][b][m][n] = (f32x4){0.f, 0.f, 0.f, 0.f};
    bf16x8 At[4][2], B0[2][2], B1[2][2];
    const char* cA = cur.a; const char* cB = cur.b;
    PG8_GOFF(gA, cur);
    if constexpr (SP2) {
        PG8_STAGE(PG8_SB(0, 0), cB, voffB); PG8_STAGE(PG8_SB(0, 1), cB + hstep, voffB); PG8_STAGE_A(PG8_SA(0, 0), cA, 0, false); PG8_STAGE_A(PG8_SA(0, 1), cA, 1, false);
        if (wr == 1) PG8_BAR;
        PG8_WAIT_V(2); PG8_BAR;
        PG8_STAGE(PG8_SB(1, 0), cB + kstep, voffB); PG8_STAGE_A(PG8_SA(1, 0), cA + kstep, 0, false); PG8_STAGE(PG8_SB(1, 1), cB + hstep + kstep, voffB);
        PG8_WAIT_V(6); PG8_BAR;
    }
    for (;;) {
        const bool has_next = S.next(ui + 1, nxt);
        const char* nA = has_next ? nxt.a : cA; const char* nB = has_next ? nxt.b : cB;
        for (int t = 0; t < nt; t += 2) {
            const bool last = (t == nt - 2);
            const char* a1 = cA + (size_t)(t + 1) * kstep;
            const char* a2 = last ? nA : cA + (size_t)(t + 2) * kstep; const char* b2 = last ? nB : cB + (size_t)(t + 2) * kstep;
            const char* a3 = a2 + kstep; const char* b3 = b2 + kstep;
            const bool NX = last;
            if constexpr (SP2) {
            PG8_LDB(B0, 0, 0); PG8_LDB(B1, 0, 1); PG8_SCHED; PG8_LDA(At, 0, 0); PG8_STAGE_A(PG8_SA(1, 1), a1, 1, false);
            if (last && has_next) PG8_GOFF(gA, nxt);
            PG8_WAIT_V(8); PG8_WAIT_L(0); PG8_BAR; PG8_MMA(0, 0, At, B0); PG8_MMA(0, 1, At, B1); PG8_BAR; PG8_SCHED;
            PG8_LDA(At, 0, 1); PG8_STAGE(PG8_SB(0, 0), b2, voffB); PG8_STAGE(PG8_SB(0, 1), b2 + hstep, voffB); PG8_STAGE_A(PG8_SA(0, 0), a2, 0, NX);
            PG8_WAIT_V(8); PG8_WAIT_L(0); PG8_BAR; PG8_MMA(1, 0, At, B0); PG8_MMA(1, 1, At, B1); PG8_BAR; PG8_SCHED;
            PG8_LDB(B0, 1, 0); PG8_LDB(B1, 1, 1); PG8_SCHED; PG8_LDA(At, 1, 0); PG8_STAGE_A(PG8_SA(0, 1), a2, 1, NX);
            PG8_WAIT_V(8); PG8_WAIT_L(0); PG8_BAR; PG8_MMA(0, 0, At, B0); PG8_MMA(0, 1, At, B1); PG8_BAR; PG8_SCHED;
            PG8_LDA(At, 1, 1); PG8_STAGE(PG8_SB(1, 0), b3, voffB); PG8_STAGE(PG8_SB(1, 1), b3 + hstep, voffB); PG8_STAGE_A(PG8_SA(1, 0), a3, 0, NX);
            PG8_WAIT_V(8); PG8_WAIT_L(0); PG8_BAR; PG8_MMA(1, 0, At, B0); PG8_MMA(1, 1, At, B1); PG8_BAR; PG8_SCHED;
            }
        }
        if constexpr (ALIGN_EPI) { if (wr == 0) PG8_BAR; }
        const bool keep = E(acc, cur, wr, wc, fr, fq);
        if (!has_next) break;
        if (!keep)
#pragma unroll
        for (int a = 0; a < 2; ++a)
#pragma unroll
            for (int b = 0; b < 2; ++b)
#pragma unroll
                for (int m = 0; m < 4; ++m)
#pragma unroll
                    for (int n = 0; n < 2; ++n) acc[a][b][m][n] = (f32x4){0.f, 0.f, 0.f, 0.f};
        cur = nxt; cA = nA; cB = nB; ++ui;
        if constexpr (ALIGN_EPI) { if (wr == 1) PG8_BAR; }
    }
    PG8_WAIT_V(0);
    if constexpr (!ALIGN_EPI) { if (wr == 0) PG8_BAR; }
    PG8_BAR;
#undef PG8_SA
#undef PG8_SB
#undef PG8_STAGE
#undef PG8_STAGE_A
#undef PG8_LDA
#undef PG8_LDB
#undef PG8_MMA
#undef PG8_WAIT_V
#undef PG8_WAIT_L
#undef PG8_BAR
#undef PG8_SCHED
#undef PG8_GOFF
}
}
#define XB_TMO      128
#define XB_XCNT(j)  (256  + 64 * (j))
#define XB_XSUB(j)  (1280 + 64 * (j))
#define XB_XGEN(j)  (2304 + 64 * (j))
#define XB_TOP      3328
#define XB_TOPGEN   3392
#define XCD_BAR_WORDS 3456
#define XB_SPIN_CAP (1u << 18)

__device__ __forceinline__ unsigned xb_ld(unsigned* p)              { return __hip_atomic_load(p, __ATOMIC_RELAXED, __HIP_MEMORY_SCOPE_AGENT); }
__device__ __forceinline__ unsigned xb_add(unsigned* p, unsigned v) { return __hip_atomic_fetch_add(p, v, __ATOMIC_RELAXED, __HIP_MEMORY_SCOPE_AGENT); }
__device__ __forceinline__ unsigned xb_xcc_id() { return (unsigned)__builtin_amdgcn_s_getreg((3 << 11) | 20) & 0xFu; }
#define XB_SPIN(cond, bar) do { unsigned _sp = 0; while (cond) { __builtin_amdgcn_s_sleep(1); \
    if ((++_sp & 255u) == 0u) { if (xb_ld(&(bar)[XB_TMO])) break; if (_sp > XB_SPIN_CAP) { atomicAdd(&(bar)[XB_TMO], 1u); break; } } } } while (0)

struct XcdBarrier {
    unsigned* bar; unsigned x;
    volatile LAS unsigned* st;
};
__device__ __forceinline__ XcdBarrier xcd_barrier_post(unsigned* bar, volatile LAS unsigned* st) {
    XcdBarrier b; b.bar = bar; b.x = xb_xcc_id(); b.st = st;
    if (threadIdx.x == 0) (void)xb_add(&bar[XB_XCNT(b.x)], 1u);
    return b;
}
__device__ __forceinline__ void xcd_barrier_complete(unsigned* bar, unsigned x, unsigned& nloc, unsigned& nx) {
    const unsigned G = gridDim.x * gridDim.y * gridDim.z;
    unsigned sum, cnt, mine, sp = 0u;
    for (;;) {
        sum = 0u; cnt = 0u; mine = 0u;
#pragma unroll
        for (unsigned j = 0; j < 16; ++j) { const unsigned c = xb_ld(&bar[XB_XCNT(j)]); sum += c; cnt += (c > 0u) ? 1u : 0u; mine = (j == x) ? c : mine; }
        if (sum == G) break;
        __builtin_amdgcn_s_sleep(1);
        if ((++sp & 255u) == 0u) { if (xb_ld(&bar[XB_TMO])) break; if (sp > XB_SPIN_CAP) { atomicAdd(&bar[XB_TMO], 1u); break; } }
    }
    nloc = mine > 0u ? mine : 1u; nx = cnt > 0u ? cnt : 1u;
}
__device__ __forceinline__ void xcd_barrier(const XcdBarrier& b) {
    asm volatile("s_waitcnt vmcnt(0)" ::: "memory");
    __syncthreads();
    if (threadIdx.x == 0) {
        unsigned* bar = b.bar;
        __builtin_amdgcn_s_waitcnt(0);
        unsigned nloc = b.st[0], nx = b.st[1];
        if (nloc == 0u) { xcd_barrier_complete(bar, b.x, nloc, nx); b.st[0] = nloc; b.st[1] = nx; }
        const unsigned old = xb_add(&bar[XB_XSUB(b.x)], 1u);
        const unsigned gen = old / nloc;
        if (old + 1u == (gen + 1u) * nloc) {
            __builtin_amdgcn_fence(__ATOMIC_RELEASE, "agent");
            asm volatile("s_waitcnt vmcnt(0)" ::: "memory");
            const unsigned og = xb_add(&bar[XB_TOP], 1u);
            const unsigned tg = og / nx;
            if (og + 1u == (tg + 1u) * nx) xb_add(&bar[XB_TOPGEN], 1u);
            else XB_SPIN(xb_ld(&bar[XB_TOPGEN]) == tg, bar);
            __builtin_amdgcn_fence(__ATOMIC_ACQUIRE, "agent");
            xb_add(&bar[XB_XGEN(b.x)], 1u);
            asm volatile("s_waitcnt vmcnt(0)" ::: "memory");
        } else {
            XB_SPIN(xb_ld(&bar[XB_XGEN(b.x)]) == gen, bar);
            __builtin_amdgcn_fence(__ATOMIC_ACQUIRE, "agent");
            asm volatile("s_waitcnt vmcnt(0)" ::: "memory");
        }
    }
    __syncthreads();
}

struct Args { const float* in[27]; float* out; unsigned char* ws; int ph_lo, ph_hi, use_bar, pad; };
struct Frame {
    LAS unsigned char* lds; volatile LAS unsigned* MISC; gu32* ctl; unsigned char* ws;
    int tid, lane, wave, vcu, G;
    unsigned long long tp0, tp1;
};
#ifndef PROBE_A
#define PROBE_A -1
#define PROBE_B -1
#endif
#define STAMP(F, id) do { if (PROBE_A >= 0) { if ((id) == PROBE_A) (F).tp0 = __builtin_amdgcn_s_memrealtime(); if ((id) == PROBE_B) (F).tp1 = __builtin_amdgcn_s_memrealtime(); } } while (0)

__device__ __forceinline__ void fourier_table_item(unsigned char* ws, int f, int lane);
__device__ __forceinline__ void router_table_item(unsigned char* ws, const float* wgrp, const float* wer, int f, int lane);
struct TrDesc { const float* src; bf16* dst; int ldw, ldk; };
constexpr int T_IN = 16 * 112, T_FO = 8 * 32, T_LO = 8 * 32, T_OUT = 16 * 32, T_SMALL = T_IN + T_FO + T_LO + T_OUT, T_GU = 32 * 2 * 16 * 16, T_D = 32 * 8 * 32, T_ALL = T_SMALL + T_GU + T_D;
constexpr int T_P0 = T_SMALL + 10240;
__device__ __forceinline__ TrDesc tr_decode(const Args& a, unsigned char* ws, int r) {
    TrDesc d;
    if (r < T_IN) { const int kb = r / 112, nb = r % 112; d.src = a.in[7] + (size_t)(64 * kb) * DIN + 32 * nb; d.ldw = DIN; d.dst = (bf16*)(ws + WS_WIN) + (size_t)(32 * nb) * 1024 + 64 * kb; d.ldk = 1024; return d; } r -= T_IN;
    if (r < T_FO) { const int kb = r / 32, nb = r % 32; d.src = a.in[15] + (size_t)(64 * kb) * 1024 + 32 * nb; d.ldw = 1024; d.dst = (bf16*)(ws + WS_WFO) + (size_t)(32 * nb) * 512 + 64 * kb; d.ldk = 512; return d; } r -= T_FO;
    if (r < T_LO) { const int kb = r / 32, nb = r % 32; d.src = a.in[16] + (size_t)(64 * kb) * 1024 + 32 * nb; d.ldw = 1024; d.dst = (bf16*)(ws + WS_WLO) + (size_t)(32 * nb) * 512 + 64 * kb; d.ldk = 512; return d; } r -= T_LO;
    if (r < T_OUT) { const int kb = r / 32, nb = r % 32; d.src = a.in[17] + (size_t)(64 * kb) * 1024 + 32 * nb; d.ldw = 1024; d.dst = (bf16*)(ws + WS_WOUT) + (size_t)(32 * nb) * 1024 + 64 * kb; d.ldk = 1024; return d; } r -= T_OUT;
    if (r < T_GU) { const int e = r >> 9, up = (r >> 8) & 1, q = r & 255, kb = q >> 4, nb = q & 15, n0 = 32 * nb, row = (n0 >> 7) * 256 + up * 128 + (n0 & 127);
        d.src = (up ? a.in[24] : a.in[23]) + (size_t)e * 1024 * 512 + (size_t)(64 * kb) * 512 + n0; d.ldw = 512; d.dst = (bf16*)(ws + WS_WGU) + ((size_t)e * 1024 + row) * 1024 + 64 * kb; d.ldk = 1024; return d; } r -= T_GU;
    { const int e = r >> 8, q = r & 255, kb = q >> 5, nb = q & 31;
        d.src = a.in[25] + (size_t)e * 512 * 1024 + (size_t)(64 * kb) * 1024 + 32 * nb; d.ldw = 1024; d.dst = (bf16*)(ws + WS_WD) + ((size_t)e * 1024 + 32 * nb) * 512 + 64 * kb; d.ldk = 512; return d; }
}
__device__ __forceinline__ void tr_load(const TrDesc& d, int lane, f32x4 (&v)[8]) {
#pragma unroll
    for (int it = 0; it < 8; ++it) { const int kk = it * 8 + (lane >> 3); v[it] = *(const GAS f32x4*)(d.src + (size_t)kk * d.ldw + 4 * (lane & 7)); }
}
__device__ __forceinline__ void tr_store(const TrDesc& d, int lane, const f32x4 (&v)[8], LAS float* scr) {
#pragma unroll
    for (int it = 0; it < 8; ++it) { const int kk = it * 8 + (lane >> 3); LAS float* p = scr + kk * 33 + 4 * (lane & 7); p[0] = v[it].x; p[1] = v[it].y; p[2] = v[it].z; p[3] = v[it].w; }
    LDS_WAIT(); asm volatile("" ::: "memory");
    const int c = lane & 7;
#pragma unroll
    for (int j = 0; j < 4; ++j) { const int n = (lane >> 3) + 8 * j; const LAS float* s = scr + (8 * c) * 33 + n;
        v4u o; o.x = pk2(s[0 * 33], s[1 * 33]); o.y = pk2(s[2 * 33], s[3 * 33]); o.z = pk2(s[4 * 33], s[5 * 33]); o.w = pk2(s[6 * 33], s[7 * 33]);
        *(GAS v4u*)(d.dst + (size_t)n * d.ldk + 8 * c) = o; }
    LDS_WAIT(); asm volatile("" ::: "memory");
}
__device__ __forceinline__ void tr_run(const Args& a, unsigned char* ws, int first, int step, int end, int lane, LAS float* scr) {
    if (first >= end) return;
    TrDesc cur = tr_decode(a, ws, first); f32x4 v[8]; tr_load(cur, lane, v);
    for (int it = first; it < end; it += step) {
        const int nx = it + step; TrDesc nd = cur; f32x4 vn[8];
        if (nx < end) { nd = tr_decode(a, ws, nx); tr_load(nd, lane, vn); }
        tr_store(cur, lane, v, scr);
        if (nx < end) { cur = nd;
#pragma unroll
            for (int q = 0; q < 8; ++q) v[q] = vn[q]; }
    }
}
constexpr int SIL_STRIDE = 1056;
__device__ __forceinline__ void p0_prologue(Frame& F, const Args& a) {
    const float* c = a.in[1]; const float* cctx = a.in[3]; const float* wmod = a.in[4]; const float* bmod = a.in[5];
    const float* lwa = a.in[10]; const float* lwx = a.in[12];
    LAS float* sil = (LAS float*)(F.lds);
    LAS float* scr = (LAS float*)(F.lds + 73728 + F.wave * 8448);
    for (int i = F.tid; i < 17 * 1024; i += NWAVES * 64) { const int r = i >> 10, k = i & 1023; const float v = r < 16 ? c[r * 1024 + k] : cctx[k];
        sil[r * SIL_STRIDE + k + 8 * (k >> 8)] = v / (1.f + expf(-v)); }
    __syncthreads();
    {
        LAS float* red = (LAS float*)(F.lds + 73728 + NWAVES * 8448);
        float* mod = (float*)(F.ws + WS_MOD);
        for (int item = (int)blockIdx.x; item < 384; item += F.G) {
            const int c0 = item * 16, ci = F.lane & 15, kq = F.lane >> 4, kb = 128 * F.wave + 32 * kq;
            const float* wp = wmod + (size_t)kb * 6144 + c0 + ci;
            float acc[17];
#pragma unroll
            for (int r = 0; r < 17; ++r) acc[r] = 0.f;
#pragma unroll 1
            for (int grp = 0; grp < 2; ++grp) {
                float w[16];
#pragma unroll
                for (int j = 0; j < 16; ++j) w[j] = wp[(size_t)(16 * grp + j) * 6144];
#pragma unroll
                for (int j4 = 0; j4 < 4; ++j4) {
#pragma unroll
                    for (int r = 0; r < 17; ++r) { const int k = kb + 16 * grp + 4 * j4; const f32x4 s = *(const LAS f32x4*)(sil + r * SIL_STRIDE + k + 8 * (k >> 8));
                        acc[r] += s[0] * w[4 * j4]; acc[r] += s[1] * w[4 * j4 + 1]; acc[r] += s[2] * w[4 * j4 + 2]; acc[r] += s[3] * w[4 * j4 + 3]; }
                    asm volatile("" ::: "memory"); }
            }
#pragma unroll
            for (int r = 0; r < 17; ++r) { float v = acc[r]; v += __shfl_xor(v, 16); v += __shfl_xor(v, 32); if (kq == 0) red[(F.wave * 17 + r) * 16 + ci] = v; }
            __syncthreads();
            if (F.tid < 17 * 16) { const int r = F.tid >> 4, cc = F.tid & 15; float v = 0.f;
#pragma unroll
                for (int ww = 0; ww < NWAVES; ++ww) v += red[(ww * 17 + r) * 16 + cc];
                mod[r * 6144 + c0 + cc] = v + bmod[c0 + cc]; }
            __syncthreads();
        }
    }
    if (blockIdx.x == F.G - 1) { const float* lba = a.in[11]; const float* lbx = a.in[13]; const float* lam = a.in[14]; f32x4* LC = (f32x4*)(F.ws + WS_WLRU + 512 * 1024);
        for (int q = F.tid; q < 1024; q += NWAVES * 64) LC[q] = (f32x4){-1.4426950409f * lba[q], -1.4426950409f * lbx[q], 8.f * log1pf(expf(-lam[q])), 0.f}; }
    const int gw = F.vcu * NWAVES + F.wave, NGW = F.G * NWAVES;
    constexpr int I_LRU = 256, I_FT = 96, I_RT = 96;
    bf16* WLRU = (bf16*)(F.ws + WS_WLRU);
    for (int r = NGW - 1 - gw; r < I_LRU + I_FT + I_RT; r += NGW) {
        if (r >= I_LRU + I_FT) { router_table_item(F.ws, a.in[19], a.in[21], r - I_LRU - I_FT, F.lane); continue; }
        if (r >= I_LRU) { fourier_table_item(F.ws, r - I_LRU, F.lane); continue; }
        {
            const int s = r & 1, ct = (r >> 1) & 3, type = (r >> 3) & 1, d = (r >> 4) & 1, h = r >> 5, i = F.lane & 15, g = F.lane >> 4;
            const float* W = (type ? lwx : lwa) + ((size_t)(d * 8 + h) * 64) * 64;
            float v[8];
#pragma unroll
            for (int j = 0; j < 8; ++j) v[j] = -1.4426950409f * W[(32 * s + 8 * g + j) * 64 + 16 * ct + i];
            v4u o; o.x = pk2(v[0], v[1]); o.y = pk2(v[2], v[3]); o.z = pk2(v[4], v[5]); o.w = pk2(v[6], v[7]);
            *(GAS v4u*)(WLRU + (size_t)r * 512 + F.lane * 8) = o;
        }
    }
    tr_run(a, F.ws, gw, NGW, T_P0, F.lane, scr);
}

__device__ __forceinline__ void p1_normmod(Frame& F, const Args& a) {
    const float* x = a.in[0]; const float* ctx = a.in[2]; const float* g = a.in[6]; const float* mod = (const float*)(F.ws + WS_MOD);
    bf16* HX = (bf16*)(F.ws + WS_HX);
    const int gw = F.vcu * NWAVES + F.wave, NGW = F.G * NWAVES;
    const int per = (NTC + NGW - 1) / NGW;
    int curmr = -1; f32x4 A[4], B[4];
    for (int v = gw * per; v < (gw + 1) * per && v < NTC; ++v) {
        const int mr = v < NT ? v / SEQ : 16;
        if (mr != curmr) { curmr = mr;
#pragma unroll
            for (int j = 0; j < 4; ++j) { const int col = 4 * F.lane + 256 * j; const f32x4 gg = *(const f32x4*)(g + col), sc = *(const f32x4*)(mod + mr * 6144 + 1024 + col);
                A[j] = gg * (1.f + sc); B[j] = *(const f32x4*)(mod + mr * 6144 + col); } }
        const float* src = v < NT ? x + (size_t)v * D : ctx + (size_t)(v - NT) * D;
        const GAS f32x4* xr = (const GAS f32x4*)src + F.lane;
        f32x4 t[4]; float ss = 0.f;
#pragma unroll
        for (int j = 0; j < 4; ++j) { t[j] = xr[64 * j]; ss += (t[j].x * t[j].x + t[j].y * t[j].y) + (t[j].z * t[j].z + t[j].w * t[j].w); }
        const float rstd = rsqrtf(wave_sum(ss) * (1.f / D) + EPS);
        GAS v2u* o8 = (GAS v2u*)(HX + (size_t)v * D) + F.lane;
#pragma unroll
        for (int j = 0; j < 4; ++j) { const f32x4 y = t[j] * rstd * A[j] + B[j]; v2u w; w.x = pk2(y.x, y.y); w.y = pk2(y.z, y.w); o8[64 * j] = w; }
    }
}

struct ProjSched {
    const char* A; const char* Bt; int G, c;
    __device__ __forceinline__ bool next(int i, pg8::Unit& u) const {
        const int L = i * G + c;
        if (L < 128 * 14) pg8::static_tile(L, 128, 14, u.pm, u.pn);
        else { const int q = L - 128 * 14; if (q >= 32) return false; u.pm = 128 + (q >> 1); u.pn = 2 + (q & 1); }
        u.a = A + (size_t)u.pm * 256 * 1024 * 2; u.b = Bt + (size_t)u.pn * 256 * 1024 * 2; u.rows = nullptr; u.nrows = 0; u.aux = 0; return true;
    }
};
struct EpiProj {
    static constexpr bool PERM = true;
    unsigned char* ws;
    __device__ __forceinline__ bool operator()(f32x4 (&acc)[2][2][4][2], const pg8::Unit& u, int wr, int wc, int fr, int fq) const {
        bf16* base; int ldc, colt, act;
        if (u.pn < 2) { base = (bf16*)(ws + WS_UF); ldc = 512; colt = 256 * u.pn; act = 0; }
        else if (u.pn < 4) { base = (bf16*)(ws + WS_UR); ldc = 512; colt = 256 * (u.pn - 2); act = 0; }
        else if (u.pn < 6) { base = (bf16*)(ws + WS_GY); ldc = 512; colt = 256 * (u.pn - 4); act = 1; }
        else if (u.pn < 10) { base = (bf16*)(ws + WS_GF); ldc = 1024; colt = 256 * (u.pn - 6); act = 2; }
        else { base = (bf16*)(ws + WS_GR); ldc = 1024; colt = 256 * (u.pn - 10); act = 2; }
        const int row0 = u.pm * 256 + wr * 64 + fr, col0 = colt + wc * 32 + 8 * fq;
#pragma unroll
        for (int ai = 0; ai < 2; ++ai)
#pragma unroll
            for (int m = 0; m < 4; ++m) { bf16* rowp = base + (size_t)(row0 + ai * 128 + m * 16) * ldc + col0;
#pragma unroll
                for (int bj = 0; bj < 2; ++bj) { f32x4 v0 = acc[ai][bj][m][0], v1 = acc[ai][bj][m][1];
                    if (act == 1) {
#pragma unroll
                        for (int j = 0; j < 4; ++j) { v0[j] = fast_gelu_tanh(v0[j]); v1[j] = fast_gelu_tanh(v1[j]); } }
                    else if (act == 2) {
#pragma unroll
                        for (int j = 0; j < 4; ++j) { v0[j] = fast_sigmoid(v0[j]); v1[j] = fast_sigmoid(v1[j]); } }
                    pg8::u32x4 w; w.x = pg8::cvt_pk_bf16(v0[0], v0[1]); w.y = pg8::cvt_pk_bf16(v0[2], v0[3]); w.z = pg8::cvt_pk_bf16(v1[0], v1[1]); w.w = pg8::cvt_pk_bf16(v1[2], v1[3]);
                    *(pg8::u32x4*)(rowp + bj * 128) = w; } }
        return false;
    }
};
struct PlainSched {
    const char* A; const char* Bt; int nM, nN, K, G, c;
    __device__ __forceinline__ bool next(int i, pg8::Unit& u) const {
        const int L = i * G + c; if (L >= nM * nN) return false;
        pg8::static_tile(L, nM, nN, u.pm, u.pn);
        u.a = A + (size_t)u.pm * 256 * K * 2; u.b = Bt + (size_t)u.pn * 256 * K * 2; u.rows = nullptr; u.nrows = 0; u.aux = 0; return true;
    }
};
struct EpiGate1 {
    static constexpr bool PERM = true;
    const bf16* GF; bf16* P1;
    __device__ __forceinline__ bool operator()(f32x4 (&acc)[2][2][4][2], const pg8::Unit& u, int wr, int wc, int fr, int fq) const {
        const int row0 = u.pm * 256 + wr * 64 + fr, col0 = u.pn * 256 + wc * 32 + 8 * fq;
#pragma unroll
        for (int ai = 0; ai < 2; ++ai)
#pragma unroll
            for (int m = 0; m < 4; ++m) { const size_t ro = (size_t)(row0 + ai * 128 + m * 16) * 1024 + col0;
#pragma unroll
                for (int bj = 0; bj < 2; ++bj) { const pg8::u32x4 g = *(const pg8::u32x4*)(GF + ro + bj * 128);
                    const f32x4 v0 = acc[ai][bj][m][0], v1 = acc[ai][bj][m][1]; pg8::u32x4 w;
                    w.x = pg8::cvt_pk_bf16(v0[0] * bf2f(g.x & 0xffffu), v0[1] * bf2f(g.x >> 16)); w.y = pg8::cvt_pk_bf16(v0[2] * bf2f(g.y & 0xffffu), v0[3] * bf2f(g.y >> 16));
                    w.z = pg8::cvt_pk_bf16(v1[0] * bf2f(g.z & 0xffffu), v1[1] * bf2f(g.z >> 16)); w.w = pg8::cvt_pk_bf16(v1[2] * bf2f(g.w & 0xffffu), v1[3] * bf2f(g.w >> 16));
                    *(pg8::u32x4*)(P1 + ro + bj * 128) = w; } }
        return false;
    }
};
struct EpiGate2 {
    static constexpr bool PERM = true;
    const bf16* GR; const bf16* P1; bf16* MG;
    __device__ __forceinline__ bool operator()(f32x4 (&acc)[2][2][4][2], const pg8::Unit& u, int wr, int wc, int fr, int fq) const {
        const int row0 = u.pm * 256 + wr * 64 + fr, col0 = u.pn * 256 + wc * 32 + 8 * fq;
#pragma unroll
        for (int ai = 0; ai < 2; ++ai)
#pragma unroll
            for (int m = 0; m < 4; ++m) { const size_t ro = (size_t)(row0 + ai * 128 + m * 16) * 1024 + col0;
#pragma unroll
                for (int bj = 0; bj < 2; ++bj) { const pg8::u32x4 g = *(const pg8::u32x4*)(GR + ro + bj * 128), p = *(const pg8::u32x4*)(P1 + ro + bj * 128);
                    const f32x4 v0 = acc[ai][bj][m][0], v1 = acc[ai][bj][m][1]; pg8::u32x4 w;
                    w.x = pg8::cvt_pk_bf16(bf2f(p.x & 0xffffu) + v0[0] * bf2f(g.x & 0xffffu), bf2f(p.x >> 16) + v0[1] * bf2f(g.x >> 16));
                    w.y = pg8::cvt_pk_bf16(bf2f(p.y & 0xffffu) + v0[2] * bf2f(g.y & 0xffffu), bf2f(p.y >> 16) + v0[3] * bf2f(g.y >> 16));
                    w.z = pg8::cvt_pk_bf16(bf2f(p.z & 0xffffu) + v1[0] * bf2f(g.z & 0xffffu), bf2f(p.z >> 16) + v1[1] * bf2f(g.z >> 16));
                    w.w = pg8::cvt_pk_bf16(bf2f(p.w & 0xffffu) + v1[2] * bf2f(g.w & 0xffffu), bf2f(p.w >> 16) + v1[3] * bf2f(g.w >> 16));
                    *(pg8::u32x4*)(MG + ro + bj * 128) = w; } }
        return false;
    }
};
struct EpiOut {
    static constexpr bool PERM = false;
    const float* x; const float* mod; float* out;
    __device__ __forceinline__ bool operator()(f32x4 (&acc)[2][2][4][2], const pg8::Unit& u, int wr, int wc, int fr, int fq) const {
        const int row0 = u.pm * 256 + wr * 64 + fr, col0 = u.pn * 256 + wc * 32 + 4 * fq; const float* g1 = mod + (u.pm >> 3) * 6144 + 2048;
        f32x4 gv[2][2];
#pragma unroll
        for (int bj = 0; bj < 2; ++bj)
#pragma unroll
            for (int n = 0; n < 2; ++n) gv[bj][n] = *(const f32x4*)(g1 + col0 + bj * 128 + n * 16);
#pragma unroll
        for (int ai = 0; ai < 2; ++ai)
#pragma unroll
            for (int m = 0; m < 4; ++m) { const size_t ro = (size_t)(row0 + ai * 128 + m * 16) * 1024 + col0;
#pragma unroll
                for (int bj = 0; bj < 2; ++bj)
#pragma unroll
                    for (int n = 0; n < 2; ++n) { const f32x4 xv = *(const f32x4*)(x + ro + bj * 128 + n * 16); *(f32x4*)(out + ro + bj * 128 + n * 16) = xv + gv[bj][n] * acc[ai][bj][m][n]; }
                asm volatile("" ::: "memory"); }
        return false;
    }
};
__device__ __forceinline__ void moe_tables(Frame& F) {
    if (F.tid < 64) { const int e = F.tid & 31; int tl = ((int)__hip_atomic_load(F.ctl + CW_CNT + e, RLX_AGENT) + 255) >> 8; int incl = tl;
#pragma unroll
        for (int o = 1; o < 32; o <<= 1) { const int v = __shfl_up(incl, o, 32); if (e >= o) incl += v; }
        if (F.tid < 32) { F.MISC[64 + e] = (unsigned)(incl - tl); if (e == 31) F.MISC[96] = (unsigned)incl; } }
    __syncthreads();
}
template <bool FIRST> struct MoeSched {
    volatile LAS unsigned* toff; const unsigned* cnt; const char* T; const int* lists; const char* H; const char* W; int G, c;
    __device__ __forceinline__ bool next(int i, pg8::Unit& u) const {
        const int L = i * G + c; const int total = (int)toff[32] * 4; if (L >= total) return false;
        const int t = L >> 2; u.pn = L & 3; int e = 0;
#pragma unroll
        for (int st = 16; st >= 1; st >>= 1) if ((int)toff[e + st] <= t) e += st;
        const int tile = t - (int)toff[e]; u.pm = t; u.aux = e;
        if (FIRST) { u.a = T; u.rows = lists + e * LIST_CAP + tile * 256; const int left = (int)cnt[e] - tile * 256; u.nrows = left < 256 ? left : 256;
            u.b = W + ((size_t)e * 1024 + (size_t)u.pn * 256) * 1024 * 2; }
        else { u.a = H + (size_t)t * 256 * 512 * 2; u.rows = nullptr; u.nrows = 0; u.b = W + ((size_t)e * 1024 + (size_t)u.pn * 256) * 512 * 2; }
        return true;
    }
};
struct EpiMoe1 {
    static constexpr bool PERM = true;
    bf16* H;
    __device__ __forceinline__ bool operator()(f32x4 (&acc)[2][2][4][2], const pg8::Unit& u, int wr, int wc, int fr, int fq) const {
        const int row0 = u.pm * 256 + wr * 64 + fr, col0 = u.pn * 128 + wc * 32 + 8 * fq;
#pragma unroll
        for (int ai = 0; ai < 2; ++ai)
#pragma unroll
            for (int m = 0; m < 4; ++m) { const f32x4 g0 = acc[ai][0][m][0], g1 = acc[ai][0][m][1], u0 = acc[ai][1][m][0], u1 = acc[ai][1][m][1]; pg8::u32x4 w;
                w.x = pg8::cvt_pk_bf16(fast_silu(g0[0]) * u0[0], fast_silu(g0[1]) * u0[1]); w.y = pg8::cvt_pk_bf16(fast_silu(g0[2]) * u0[2], fast_silu(g0[3]) * u0[3]);
                w.z = pg8::cvt_pk_bf16(fast_silu(g1[0]) * u1[0], fast_silu(g1[1]) * u1[1]); w.w = pg8::cvt_pk_bf16(fast_silu(g1[2]) * u1[2], fast_silu(g1[3]) * u1[3]);
                *(pg8::u32x4*)(H + (size_t)(row0 + ai * 128 + m * 16) * 512 + col0) = w; }
        return false;
    }
};
struct EpiY {
    static constexpr bool PERM = true;
    bf16* Y;
    __device__ __forceinline__ bool operator()(f32x4 (&acc)[2][2][4][2], const pg8::Unit& u, int wr, int wc, int fr, int fq) const {
        const int row0 = u.pm * 256 + wr * 64 + fr, col0 = u.pn * 256 + wc * 32 + 8 * fq;
#pragma unroll
        for (int ai = 0; ai < 2; ++ai)
#pragma unroll
            for (int m = 0; m < 4; ++m)
#pragma unroll
                for (int bj = 0; bj < 2; ++bj) { const f32x4 v0 = acc[ai][bj][m][0], v1 = acc[ai][bj][m][1]; pg8::u32x4 w;
                    w.x = pg8::cvt_pk_bf16(v0[0], v0[1]); w.y = pg8::cvt_pk_bf16(v0[2], v0[3]); w.z = pg8::cvt_pk_bf16(v1[0], v1[1]); w.w = pg8::cvt_pk_bf16(v1[2], v1[3]);
                    *(pg8::u32x4*)(Y + (size_t)(row0 + ai * 128 + m * 16) * 1024 + col0 + bj * 128) = w; }
        return false;
    }
};
__device__ __forceinline__ void p_final(Frame& F, const Args& a, float* dst) {
    const float* mod = (const float*)(F.ws + WS_MOD); const float* fg = a.in[26]; float* out = a.out;
    const int* tokinfo = (const int*)(F.ws + WS_TOKINFO); const bf16* Y = (const bf16*)(F.ws + WS_Y);
    const int gw = F.vcu * NWAVES + F.wave, NGW = F.G * NWAVES, per = NT / NGW;
    for (int t0 = gw * per; t0 < NT; t0 += NGW * per) {
        const int b = t0 / SEQ;
        f32x4 g2[2][2], fgv[2][2];
#pragma unroll
        for (int j = 0; j < 2; ++j)
#pragma unroll
            for (int h = 0; h < 2; ++h) { const int col = 8 * F.lane + 512 * j + 4 * h; g2[j][h] = *(const f32x4*)(mod + b * 6144 + 5120 + col); fgv[j][h] = *(const f32x4*)(fg + col); }
        for (int t = t0; t < t0 + per; ++t) {
            const int* ti = tokinfo + t * 8; const int e0 = ti[0], p0 = ti[1], e1 = ti[2], p1 = ti[3]; const float w0 = ((const float*)ti)[4], w1 = ((const float*)ti)[5];
            const bf16* y0 = Y + ((size_t)F.MISC[64 + e0] * 256 + p0) * 1024; const bf16* y1 = Y + ((size_t)F.MISC[64 + e1] * 256 + p1) * 1024;
            float* xr = out + (size_t)t * 1024;
            f32x4 v[2][2]; float ss = 0.f;
#pragma unroll
            for (int j = 0; j < 2; ++j) { const int col = 8 * F.lane + 512 * j;
                const pg8::u32x4 a0 = *(const pg8::u32x4*)(y0 + col), a1 = *(const pg8::u32x4*)(y1 + col);
                f32x4 m0, m1;
                m0[0] = w0 * bf2f(a0.x & 0xffffu) + w1 * bf2f(a1.x & 0xffffu); m0[1] = w0 * bf2f(a0.x >> 16) + w1 * bf2f(a1.x >> 16);
                m0[2] = w0 * bf2f(a0.y & 0xffffu) + w1 * bf2f(a1.y & 0xffffu); m0[3] = w0 * bf2f(a0.y >> 16) + w1 * bf2f(a1.y >> 16);
                m1[0] = w0 * bf2f(a0.z & 0xffffu) + w1 * bf2f(a1.z & 0xffffu); m1[1] = w0 * bf2f(a0.z >> 16) + w1 * bf2f(a1.z >> 16);
                m1[2] = w0 * bf2f(a0.w & 0xffffu) + w1 * bf2f(a1.w & 0xffffu); m1[3] = w0 * bf2f(a0.w >> 16) + w1 * bf2f(a1.w >> 16);
                v[j][0] = *(const f32x4*)(xr + col) + g2[j][0] * m0; v[j][1] = *(const f32x4*)(xr + col + 4) + g2[j][1] * m1;
#pragma unroll
                for (int h = 0; h < 2; ++h) ss += (v[j][h][0] * v[j][h][0] + v[j][h][1] * v[j][h][1]) + (v[j][h][2] * v[j][h][2] + v[j][h][3] * v[j][h][3]); }
            const float rstd = rsqrtf(wave_sum(ss) * (1.f / D) + EPS);
#pragma unroll
            for (int j = 0; j < 2; ++j)
#pragma unroll
                for (int h = 0; h < 2; ++h) *(f32x4*)(dst + (size_t)t * 1024 + 8 * F.lane + 512 * j + 4 * h) = v[j][h] * rstd * fgv[j][h];
        }
    }
}

struct PairSched {
    const char* A0; const char* B0; const char* A1; const char* B1; int G, c;
    __device__ __forceinline__ bool next(int i, pg8::Unit& u) const {
        const int L = (i >> 1) * G + c; if (L >= 128 * 4) return false;
        pg8::static_tile(L, 128, 4, u.pm, u.pn); u.aux = i & 1;
        u.a = (u.aux ? A1 : A0) + (size_t)u.pm * 256 * 512 * 2; u.b = (u.aux ? B1 : B0) + (size_t)u.pn * 256 * 512 * 2; u.rows = nullptr; u.nrows = 0; return true;
    }
};
struct EpiMerge {
    static constexpr bool PERM = true;
    const bf16* GF; const bf16* GR; bf16* MG;
    __device__ __forceinline__ bool operator()(f32x4 (&acc)[2][2][4][2], const pg8::Unit& u, int wr, int wc, int fr, int fq) const {
        const int row0 = u.pm * 256 + wr * 64 + fr, col0 = u.pn * 256 + wc * 32 + 8 * fq;
        if (u.aux == 0) {
#pragma unroll
            for (int ai = 0; ai < 2; ++ai)
#pragma unroll
                for (int m = 0; m < 4; ++m) { const size_t ro = (size_t)(row0 + ai * 128 + m * 16) * 1024 + col0;
#pragma unroll
                    for (int bj = 0; bj < 2; ++bj) { const pg8::u32x4 gf = *(const pg8::u32x4*)(GF + ro + bj * 128), gr = *(const pg8::u32x4*)(GR + ro + bj * 128);
                        const unsigned f[4] = {gf.x, gf.y, gf.z, gf.w}, r[4] = {gr.x, gr.y, gr.z, gr.w};
#pragma unroll
                        for (int q = 0; q < 4; ++q) { const float r0 = bf2f(f[q] & 0xffffu) * __builtin_amdgcn_rcpf(fmaxf(bf2f(r[q] & 0xffffu), 1e-30f)), r1 = bf2f(f[q] >> 16) * __builtin_amdgcn_rcpf(fmaxf(bf2f(r[q] >> 16), 1e-30f));
                            acc[ai][bj][m][q >> 1][2 * (q & 1)] *= r0; acc[ai][bj][m][q >> 1][2 * (q & 1) + 1] *= r1; } } }
            return true;
        }
#pragma unroll
        for (int ai = 0; ai < 2; ++ai)
#pragma unroll
            for (int m = 0; m < 4; ++m) { const size_t ro = (size_t)(row0 + ai * 128 + m * 16) * 1024 + col0;
#pragma unroll
                for (int bj = 0; bj < 2; ++bj) { const pg8::u32x4 g = *(const pg8::u32x4*)(GR + ro + bj * 128);
                    const f32x4 v0 = acc[ai][bj][m][0], v1 = acc[ai][bj][m][1]; pg8::u32x4 w;
                    w.x = pk2(v0[0] * bf2f(g.x & 0xffffu), v0[1] * bf2f(g.x >> 16)); w.y = pk2(v0[2] * bf2f(g.y & 0xffffu), v0[3] * bf2f(g.y >> 16));
                    w.z = pk2(v1[0] * bf2f(g.z & 0xffffu), v1[1] * bf2f(g.z >> 16)); w.w = pk2(v1[2] * bf2f(g.w & 0xffffu), v1[3] * bf2f(g.w >> 16));
                    *(pg8::u32x4*)(MG + ro + bj * 128) = w; } }
        return false;
    }
};
constexpr size_t WS_RTAB = WS_WLRU + 768 * 1024;
constexpr int RT_STRIDE = 1028;
__device__ __forceinline__ void p8_route(Frame& F, const Args& a, const bool dispatch = true) {
    const float* x1 = a.out; const float* g2n = a.in[18]; const float* mod = (const float*)(F.ws + WS_MOD);
    const float* wgrp = a.in[19]; const float* bgrp = a.in[20]; const float* wer = a.in[21]; const float* ber = a.in[22];
    bf16* T = (bf16*)(F.ws + WS_T); int* tokinfo = (int*)(F.ws + WS_TOKINFO); int* lists = (int*)(F.ws + WS_LISTS);
    LAS float* tile = (LAS float*)F.lds;
    LAS float* part = (LAS float*)(F.lds + 16 * RT_STRIDE * 4);
    LAS float* lgs = (LAS float*)(F.lds + 16 * RT_STRIDE * 4 + 8 * 16 * 48 * 4);
    LAS int* beid = (LAS int*)(F.lds + 16 * RT_STRIDE * 4 + 8 * 16 * 48 * 4 + 16 * 48 * 4);
    const int w = F.wave, lane = F.lane, i16 = lane & 15, g = lane >> 4;
    const int tpb = (NT / 16 + F.G - 1) / F.G;
    const int tile0 = (int)blockIdx.x * tpb;
    bf16x8 Whi[3][4], Wlo[3][4];
    { const GAS bf16x8* tab = (const GAS bf16x8*)(F.ws + WS_RTAB);
#pragma unroll
    for (int nt = 0; nt < 3; ++nt)
#pragma unroll
        for (int s = 0; s < 4; ++s) { const int f = (w * 3 + nt) * 4 + s; Whi[nt][s] = tab[(size_t)f * 64 + lane]; Wlo[nt][s] = tab[(size_t)(96 + f) * 64 + lane]; } }
    int curb = -1; f32x4 A2[4], B2[4];
    f32x4 tn[2][4];
    auto load_rows = [&](int tt_) {
#pragma unroll
        for (int rr = 0; rr < 2; ++rr) { const GAS f32x4* xr = (const GAS f32x4*)(x1 + (size_t)(tt_ * 16 + 2 * w + rr) * D) + lane;
#pragma unroll
            for (int j = 0; j < 4; ++j) tn[rr][j] = xr[64 * j]; } };
    if (tile0 < NT / 16) load_rows(tile0);
    for (int tl = 0; tl < tpb; ++tl) {
        const int tt = tile0 + tl; if (tt >= NT / 16) break;
        const int b = (tt * 16) / SEQ;
        if (b != curb) { curb = b;
#pragma unroll
            for (int j = 0; j < 4; ++j) { const int col = 4 * lane + 256 * j; const f32x4 gg = *(const f32x4*)(g2n + col), sc = *(const f32x4*)(mod + b * 6144 + 4096 + col);
                A2[j] = gg * (1.f + sc); B2[j] = *(const f32x4*)(mod + b * 6144 + 3072 + col); } }
#pragma unroll
        for (int rr = 0; rr < 2; ++rr) { const int r = 2 * w + rr, tok = tt * 16 + r;
            float ss = 0.f;
#pragma unroll
            for (int j = 0; j < 4; ++j) { const f32x4 t = tn[rr][j]; ss += (t.x * t.x + t.y * t.y) + (t.z * t.z + t.w * t.w); }
            const float rstd = rsqrtf(wave_sum(ss) * (1.f / D) + EPS);
            GAS v2u* o8 = (GAS v2u*)(T + (size_t)tok * D) + lane;
#pragma unroll
            for (int j = 0; j < 4; ++j) { const f32x4 y = tn[rr][j] * rstd * A2[j] + B2[j];
                *(LAS f32x4*)(tile + r * RT_STRIDE + 4 * lane + 256 * j) = y;
                v2u wv; wv.x = pk2(y.x, y.y); wv.y = pk2(y.z, y.w); o8[64 * j] = wv; } }
        if (tl + 1 < tpb && tt + 1 < NT / 16) load_rows(tt + 1);
        __syncthreads();
        f32x4 acc[3];
#pragma unroll
        for (int nt = 0; nt < 3; ++nt) acc[nt] = (f32x4){0.f, 0.f, 0.f, 0.f};
#pragma unroll
        for (int s = 0; s < 4; ++s) {
            const LAS float* p = tile + i16 * RT_STRIDE + 128 * w + 32 * s + 8 * g;
            const f32x4 v0 = *(const LAS f32x4*)p, v1 = *(const LAS f32x4*)(p + 4);
            v4u ph, pl;
            ph.x = pk2(v0[0], v0[1]); ph.y = pk2(v0[2], v0[3]); ph.z = pk2(v1[0], v1[1]); ph.w = pk2(v1[2], v1[3]);
            pl.x = pk2(v0[0] - bf2f(ph.x & 0xffffu), v0[1] - __builtin_bit_cast(float, ph.x & 0xffff0000u)); pl.y = pk2(v0[2] - bf2f(ph.y & 0xffffu), v0[3] - __builtin_bit_cast(float, ph.y & 0xffff0000u));
            pl.z = pk2(v1[0] - bf2f(ph.z & 0xffffu), v1[1] - __builtin_bit_cast(float, ph.z & 0xffff0000u)); pl.w = pk2(v1[2] - bf2f(ph.w & 0xffffu), v1[3] - __builtin_bit_cast(float, ph.w & 0xffff0000u));
            const bf16x8 Ahi = __builtin_bit_cast(bf16x8, ph), Alo = __builtin_bit_cast(bf16x8, pl);
#pragma unroll
            for (int nt = 0; nt < 3; ++nt) {
                acc[nt] = __builtin_amdgcn_mfma_f32_16x16x32_bf16(Ahi, Whi[nt][s], acc[nt], 0, 0, 0);
                acc[nt] = __builtin_amdgcn_mfma_f32_16x16x32_bf16(Ahi, Wlo[nt][s], acc[nt], 0, 0, 0);
                acc[nt] = __builtin_amdgcn_mfma_f32_16x16x32_bf16(Alo, Whi[nt][s], acc[nt], 0, 0, 0); }
        }
#pragma unroll
        for (int nt = 0; nt < 3; ++nt)
#pragma unroll
            for (int q = 0; q < 4; ++q) part[(w * 16 + 4 * g + q) * 48 + 16 * nt + i16] = acc[nt][q];
        __syncthreads();
        for (int q = F.tid; q < 16 * 48; q += NWAVES * 64) { const int r = q / 48, n = q - 48 * r; float s = 0.f;
#pragma unroll
            for (int ww = 0; ww < 8; ++ww) s += part[(ww * 16 + r) * 48 + n];
            if (n < 36) s += (n < 4 ? bgrp[n] : ber[n - 4]);
            lgs[q] = s; }
        __syncthreads();
        if (F.tid < 16) { const int r = F.tid, tok = tt * 16 + r; const LAS float* lg = lgs + r * 48;
            int grp = 0; float mx = lg[0];
            for (int q = 1; q < 4; ++q) { const float v = lg[q]; if (v > mx) { mx = v; grp = q; } }
            float den = 0.f;
            for (int q = 0; q < 4; ++q) den += expf(lg[q] - mx);
            const float pg = 1.f / den;
            const LAS float* el = lg + 4 + grp * 8;
            int i0 = 0; float l0 = el[0];
            for (int e = 1; e < 8; ++e) { const float v = el[e]; if (v > l0) { l0 = v; i0 = e; } }
            int i1 = (i0 + 1) & 7; float l1 = el[i1];
            for (int e = 0; e < 8; ++e) { const float v = el[e]; if (e != i0 && v > l1) { l1 = v; i1 = e; } }
            const float e1 = expf(l1 - l0), w0 = pg / (1.f + e1), w1 = pg * e1 / (1.f + e1);
            const int id0 = grp * 8 + i0, id1 = grp * 8 + i1;
            beid[(tl * 16 + r) * 2] = id0; beid[(tl * 16 + r) * 2 + 1] = id1;
            int* ti = tokinfo + tok * 8; ti[0] = id0; ti[2] = id1; ((float*)ti)[4] = w0; ((float*)ti)[5] = w1;
        }
    }
    __syncthreads();
    const int ntl = (NT / 16 - tile0) < tpb ? (NT / 16 - tile0) : tpb;
    if (dispatch && F.tid < 32 && ntl > 0) { const int e = F.tid, na = ntl * 32; int c = 0;
        for (int q = 0; q < na; ++q) c += (beid[q] == e) ? 1 : 0;
        if (c > 0) { const int base = (int)__hip_atomic_fetch_add(F.ctl + CW_CNT + e, (unsigned)c, RLX_AGENT); int j = 0;
            for (int q = 0; q < na; ++q) if (beid[q] == e) { const int tok = tile0 * 16 + (q >> 1); lists[e * LIST_CAP + base + j] = tok; tokinfo[tok * 8 + 1 + 2 * (q & 1)] = base + j; ++j; } }
    }
}

__device__ __forceinline__ void router_table_item(unsigned char* ws, const float* wgrp, const float* wer, int f, int lane) {
    const int s = f & 3, nt = (f >> 2) % 3, w = f / 12, i = lane & 15, g = lane >> 4, n = 16 * nt + i; unsigned hi[8], lo[8];
#pragma unroll
    for (int j = 0; j < 8; ++j) { const int k = 128 * w + 32 * s + 8 * g + j; const float v = n < 4 ? wgrp[k * 4 + n] : (n < 36 ? wer[k * 32 + (n - 4)] : 0.f); hi[j] = f2bf(v); lo[j] = f2bf(v - bf2f(hi[j])); }
    v4u ph, pl; ph.x = hi[0] | (hi[1] << 16); ph.y = hi[2] | (hi[3] << 16); ph.z = hi[4] | (hi[5] << 16); ph.w = hi[6] | (hi[7] << 16);
    pl.x = lo[0] | (lo[1] << 16); pl.y = lo[2] | (lo[3] << 16); pl.z = lo[4] | (lo[5] << 16); pl.w = lo[6] | (lo[7] << 16);
    *(GAS v4u*)(ws + WS_RTAB + (size_t)f * 1024 + lane * 16) = ph; *(GAS v4u*)(ws + WS_RTAB + (size_t)(96 + f) * 1024 + lane * 16) = pl;
}
constexpr int FA_T1_OFF = 2048, FA_B2_OFF = FA_T1_OFF + 65536;
constexpr size_t WS_FTAB = WS_WLRU + 640 * 1024;
__device__ __forceinline__ void fourier_table_item(unsigned char* ws, int f, int lane) {
    const int i = lane & 15, g = lane >> 4; unsigned h[8];
    if (f < 64) { const int s = f & 3, p = (f >> 2) & 1, qb = f >> 3, q = 16 * qb + i;
#pragma unroll
        for (int j = 0; j < 8; ++j) { const int k = 32 * s + 8 * g + j, idx = (k * q) & 127; const float ang = (float)idx * (1.f / 64.f); h[j] = f2bf(p == 0 ? cospif(ang) : -sinpif(ang)); } }
    else { const int ff = f - 64, nt = ff & 7, s2 = (ff >> 3) & 1, p = ff >> 4, col = 16 * nt + i, po = col >> 6, cp = col & 63;
#pragma unroll
        for (int j = 0; j < 8; ++j) { const int c = j < 4 ? 32 * s2 + 4 * g + j : 32 * s2 + 16 + 4 * g + (j - 4), idx = (c * cp) & 63; const float ang = (float)idx * (1.f / 32.f);
            const float cs = cospif(ang), sn = sinpif(ang); h[j] = f2bf(p == 0 ? (po == 0 ? cs : -sn) : (po == 0 ? sn : cs)); } }
    v4u w; w.x = h[0] | (h[1] << 16); w.y = h[2] | (h[3] << 16); w.z = h[4] | (h[5] << 16); w.w = h[6] | (h[7] << 16);
    *(GAS v4u*)(ws + WS_FTAB + (size_t)f * 1024 + lane * 16) = w;
}
__device__ __forceinline__ void fourierA_tables(Frame& F) {
    const GAS v4u* src = (const GAS v4u*)(F.ws + WS_FTAB); LAS v4u* dst = (LAS v4u*)(F.lds + FA_T1_OFF);
#pragma unroll
    for (int q = 0; q < 12; ++q) dst[F.tid + q * 512] = src[F.tid + q * 512];
    __syncthreads();
}
__device__ __forceinline__ void fourierA_unit(Frame& F, int b, int r, int gch) {
    const int lane = F.lane, i = lane & 15, g = lane >> 4;
    const bf16* UF = (const bf16*)(F.ws + WS_UF); bf16* Z2 = (bf16*)(F.ws + WS_HX);
    const LAS unsigned char* T1 = F.lds + FA_T1_OFF; const LAS unsigned char* B2 = F.lds + FA_B2_OFF;
    bf16x8 U[4][4];
#pragma unroll
    for (int m = 0; m < 4; ++m)
#pragma unroll
        for (int s = 0; s < 4; ++s) U[m][s] = *(const GAS bf16x8*)(UF + ((size_t)(b * SEQ + r * 64 + 16 * m + i)) * 512 + gch * 128 + 32 * s + 8 * g);
    bf16* zbase = Z2 + ((size_t)((b * 4 + gch) * 32 + r) * 2) * 64 * 128;
    for (int qb = 0; qb < 8; ++qb) {
        f32x4 X[2][4];
#pragma unroll
        for (int p = 0; p < 2; ++p)
#pragma unroll
            for (int m = 0; m < 4; ++m) X[p][m] = (f32x4){0.f, 0.f, 0.f, 0.f};
#pragma unroll
        for (int p = 0; p < 2; ++p)
#pragma unroll
            for (int s = 0; s < 4; ++s) { const bf16x8 tf = *(const LAS bf16x8*)(T1 + (((qb * 2 + p) * 4 + s) * 64 + lane) * 16);
#pragma unroll
                for (int m = 0; m < 4; ++m) X[p][m] = __builtin_amdgcn_mfma_f32_16x16x32_bf16(U[m][s], tf, X[p][m], 0, 0, 0); }
        bf16x8 XA[2][2];
#pragma unroll
        for (int p = 0; p < 2; ++p)
#pragma unroll
            for (int s2 = 0; s2 < 2; ++s2) { const f32x4 lo = X[p][2 * s2], hi = X[p][2 * s2 + 1]; v4u w;
                w.x = pg8::cvt_pk_bf16(lo[0], lo[1]); w.y = pg8::cvt_pk_bf16(lo[2], lo[3]); w.z = pg8::cvt_pk_bf16(hi[0], hi[1]); w.w = pg8::cvt_pk_bf16(hi[2], hi[3]);
                XA[p][s2] = __builtin_bit_cast(bf16x8, w); }
        f32x4 D2[8];
#pragma unroll
        for (int nt = 0; nt < 8; ++nt) D2[nt] = (f32x4){0.f, 0.f, 0.f, 0.f};
#pragma unroll
        for (int p = 0; p < 2; ++p)
#pragma unroll
            for (int s2 = 0; s2 < 2; ++s2)
#pragma unroll
                for (int nt = 0; nt < 8; ++nt) { const bf16x8 bfr = *(const LAS bf16x8*)(B2 + ((((p * 2 + s2) * 8 + nt) * 64) + lane) * 16);
                    D2[nt] = __builtin_amdgcn_mfma_f32_16x16x32_bf16(XA[p][s2], bfr, D2[nt], 0, 0, 0); }
#pragma unroll
        for (int nt = 0; nt < 8; ++nt) { const int col = 16 * nt + i; v2u w; w.x = pg8::cvt_pk_bf16(D2[nt][0], D2[nt][1]); w.y = pg8::cvt_pk_bf16(D2[nt][2], D2[nt][3]);
            *(GAS v2u*)(zbase + (size_t)col * 128 + 16 * qb + 4 * g) = w; }
    }
}
constexpr int FB_STRIDE = 272;
__device__ __forceinline__ void fourierB_unit(Frame& F, int b, int gch, int cp, const bf16x8 (&TW)[2][2]) {
    const int lane = F.lane, i = lane & 15, g = lane >> 4;
    const bf16* Z2 = (const bf16*)(F.ws + WS_HX); bf16* Fo = (bf16*)(F.ws + WS_UF);
    LAS unsigned char* tile = F.lds + F.wave * (64 * FB_STRIDE);
#pragma unroll 4
    for (int it = 0; it < 16; ++it) { const int k = it * 4 + (lane >> 4), part = k >> 5, r = k & 31;
        const v4u v = *(const GAS v4u*)(Z2 + ((size_t)(((b * 4 + gch) * 32 + r) * 2 + part) * 64 + cp) * 128 + 8 * (lane & 15));
        *(LAS v4u*)(tile + k * FB_STRIDE + 16 * (lane & 15)) = v; }
    LDS_WAIT(); asm volatile("" ::: "memory");
    f32x4 acc[8][2];
#pragma unroll
    for (int mt = 0; mt < 8; ++mt) { acc[mt][0] = (f32x4){0.f, 0.f, 0.f, 0.f}; acc[mt][1] = (f32x4){0.f, 0.f, 0.f, 0.f}; }
    const unsigned tbase = (unsigned)(size_t)tile + (unsigned)(((lane & 15) >> 2) * FB_STRIDE + 8 * (lane & 3));
#pragma unroll
    for (int mt = 0; mt < 8; ++mt)
#pragma unroll
        for (int s = 0; s < 2; ++s) { v2u t0, t1;
            const unsigned a0 = tbase + (unsigned)((32 * s + 8 * g) * FB_STRIDE + 32 * mt), a1 = a0 + 4 * FB_STRIDE;
            asm volatile("ds_read_b64_tr_b16 %0, %2\n\tds_read_b64_tr_b16 %1, %3\n\ts_waitcnt lgkmcnt(0)" : "=&v"(t0), "=&v"(t1) : "v"(a0), "v"(a1) : "memory");
            v4u w; w.x = t0.x; w.y = t0.y; w.z = t1.x; w.w = t1.y; const bf16x8 af = __builtin_bit_cast(bf16x8, w);
            acc[mt][0] = __builtin_amdgcn_mfma_f32_16x16x32_bf16(af, TW[s][0], acc[mt][0], 0, 0, 0);
            acc[mt][1] = __builtin_amdgcn_mfma_f32_16x16x32_bf16(af, TW[s][1], acc[mt][1], 0, 0, 0); }
#pragma unroll
    for (int mt = 0; mt < 8; ++mt)
#pragma unroll
        for (int nt = 0; nt < 2; ++nt) { const int rp = 16 * nt + i; const f32x4 v = acc[mt][nt] * (1.f / 512.f); v2u w; w.x = pg8::cvt_pk_bf16(v[0], v[1]); w.y = pg8::cvt_pk_bf16(v[2], v[3]);
            *(GAS v2u*)(Fo + ((size_t)(b * SEQ + rp * 64 + cp)) * 512 + gch * 128 + 16 * mt + 4 * g) = w; }
    asm volatile("" ::: "memory");
}
__device__ __forceinline__ void fourierB_twiddles(int lane, bf16x8 (&TW)[2][2]) {
    const int i = lane & 15, g = lane >> 4;
#pragma unroll
    for (int s = 0; s < 2; ++s)
#pragma unroll
        for (int nt = 0; nt < 2; ++nt) { unsigned h[8];
#pragma unroll
            for (int j = 0; j < 8; ++j) { const int r = 8 * g + j, rp = 16 * nt + i, idx = (r * rp) & 31; const float ang = (float)idx * (1.f / 16.f);
                h[j] = f2bf(s == 0 ? cospif(ang) : sinpif(ang)); }
            v4u w; w.x = h[0] | (h[1] << 16); w.y = h[2] | (h[3] << 16); w.z = h[4] | (h[5] << 16); w.w = h[6] | (h[7] << 16); TW[s][nt] = __builtin_bit_cast(bf16x8, w); }
}
constexpr int LRU_STRIDE = 144;
constexpr int LRU_WAVE_BYTES = 2 * 64 * LRU_STRIDE;
constexpr int SUM_CHUNKS = 48;
constexpr size_t WS_LRUC = WS_WLRU + 512 * 1024;
__device__ __forceinline__ size_t sum_index(int b, int chunk, int dir, int ch) { return ((((size_t)b * SUM_CHUNKS + chunk) * 2 + dir) * 512 + ch) * 2; }

__device__ __forceinline__ void lru_carry(const float* SUM, int b, int lc, int ch, float& Hf, float& Hb) {
    float H = 0.f;
#pragma unroll 16
    for (int c = 0; c < lc; ++c) { const f32x2 v = *(const f32x2*)(SUM + sum_index(b, c, 0, ch)); H = v.x * H + v.y; }
    Hf = H; H = 0.f;
#pragma unroll 16
    for (int c = 15; c >= 0; --c) { const f32x2 v = *(const f32x2*)(SUM + sum_index(b, c, 1, ch)); H = v.x * H + v.y; }
#pragma unroll 16
    for (int c = SUM_CHUNKS - 1; c > lc; --c) { const f32x2 v = *(const f32x2*)(SUM + sum_index(b, c, 1, ch)); H = v.x * H + v.y; }
    Hb = H;
}

template <int MT, int PASS, bool BLOB>
__device__ __forceinline__ void lru_unit(Frame& F, const Args& a, int b, int seqbase, int Lseq, int pos0, int h, int sumchunk, unsigned char* blob) {
    constexpr int L = 16 * MT, NG = 64 / L, CPG = 8 / NG, NTOK = 4 * MT;
    const int lane = F.lane, i16 = lane & 15, g = lane >> 4;
    const bf16* UR = (const bf16*)(F.ws + WS_UR); const bf16* GY = (const bf16*)(F.ws + WS_GY); bf16* R = (bf16*)(F.ws + WS_R);
    const bf16* WL = (const bf16*)(F.ws + WS_WLRU); float* SUM = (float*)(F.ws + WS_LRUSUM); const f32x4* LC = (const f32x4*)(F.ws + WS_LRUC);
    const float* convw = a.in[8]; const float* convb = a.in[9];
    LAS unsigned char* xt = F.lds + F.wave * LRU_WAVE_BYTES; LAS unsigned char* gt = xt + 64 * LRU_STRIDE;
    bf16x8 Bn[4];
#define LRU_LOADB(dst, ct_, dir_) do { _Pragma("unroll") for (int _ty = 0; _ty < 2; ++_ty) _Pragma("unroll") for (int _s = 0; _s < 2; ++_s) \
        dst[_ty * 2 + _s] = *(const GAS bf16x8*)(WL + (size_t)(((((h * 2 + (dir_)) * 2 + _ty) * 4 + (ct_)) * 2 + _s)) * 512 + lane * 8); } while (0)
    LRU_LOADB(Bn, 0, 0);
    {
        const int t = lane % L, grp = lane / L, p = pos0 + t;
#pragma unroll
        for (int q = 0; q < CPG; ++q) { const int cc = grp * CPG + q, ch0 = h * 64 + 8 * cc; float s[8];
#pragma unroll
            for (int j = 0; j < 8; ++j) s[j] = convb[ch0 + j];
#pragma unroll
            for (int k = 0; k < 4; ++k) { const int pp = p + k - 2;
                if (pp >= 0 && pp < Lseq) { const v4u u = *(const GAS v4u*)(UR + (size_t)(seqbase + pp) * 512 + ch0); const float* w = convw + k * 512 + ch0;
                    s[0] += w[0] * bf2f(u.x & 0xffffu); s[1] += w[1] * bf2f(u.x >> 16); s[2] += w[2] * bf2f(u.y & 0xffffu); s[3] += w[3] * bf2f(u.y >> 16);
                    s[4] += w[4] * bf2f(u.z & 0xffffu); s[5] += w[5] * bf2f(u.z >> 16); s[6] += w[6] * bf2f(u.w & 0xffffu); s[7] += w[7] * bf2f(u.w >> 16); } }
            v4u o; o.x = pk2(s[0], s[1]); o.y = pk2(s[2], s[3]); o.z = pk2(s[4], s[5]); o.w = pk2(s[6], s[7]);
            *(LAS v4u*)(xt + t * LRU_STRIDE + 16 * cc) = o;
}
    }
    LDS_WAIT(); asm volatile("" ::: "memory");
    bf16x8 Af[MT][2];
    const int tokA = NTOK * (i16 >> 2) + (i16 & 3);
#pragma unroll
    for (int m = 0; m < MT; ++m)
#pragma unroll
        for (int s = 0; s < 2; ++s) Af[m][s] = *(const LAS bf16x8*)(xt + (tokA + 4 * m) * LRU_STRIDE + (32 * s + 8 * g) * 2);
    const int tokD = NTOK * g;
#pragma unroll 1
    for (int ct = 0; ct < 4; ++ct) {
        const int ch = h * 64 + 16 * ct + i16;
        float xcv[NTOK], hf[NTOK], pfv[NTOK], pbv[NTOK];
#pragma unroll
        for (int n = 0; n < NTOK; ++n) { xcv[n] = bf2f((unsigned)*(const LAS unsigned short*)(xt + (tokD + n) * LRU_STRIDE + (16 * ct + i16) * 2));
}
#pragma unroll
        for (int dir = 0; dir < 2; ++dir) {
            bf16x8 Bc[4];
#pragma unroll
            for (int q = 0; q < 4; ++q) Bc[q] = Bn[q];
            if (dir == 0) LRU_LOADB(Bn, ct, 1); else LRU_LOADB(Bn, (ct + 1) & 3, 0);
            const f32x4 lc = LC[dir * 512 + ch];
            f32x4 ca[MT], cx[MT];
#pragma unroll
            for (int m = 0; m < MT; ++m) { ca[m] = (f32x4){lc.x, lc.x, lc.x, lc.x}; cx[m] = (f32x4){lc.y, lc.y, lc.y, lc.y}; }
#pragma unroll
            for (int s = 0; s < 2; ++s)
#pragma unroll
                for (int m = 0; m < MT; ++m) { ca[m] = __builtin_amdgcn_mfma_f32_16x16x32_bf16(Af[m][s], Bc[s], ca[m], 0, 0, 0); cx[m] = __builtin_amdgcn_mfma_f32_16x16x32_bf16(Af[m][s], Bc[2 + s], cx[m], 0, 0, 0); }
            float Av[NTOK], Bv[NTOK];
#pragma unroll
            for (int m = 0; m < MT; ++m)
#pragma unroll
                for (int q = 0; q < 4; q += 2) { const int n = 4 * m + q;
                    f32x2 ea, ex; ea.x = __builtin_amdgcn_exp2f(ca[m][q]); ea.y = __builtin_amdgcn_exp2f(ca[m][q + 1]); ex.x = __builtin_amdgcn_exp2f(cx[m][q]); ex.y = __builtin_amdgcn_exp2f(cx[m][q + 1]);
                    ea = ea + 1.f; ex = ex + 1.f;
                    const f32x2 den = ea * ex; f32x2 rc; rc.x = __builtin_amdgcn_rcpf(den.x); rc.y = __builtin_amdgcn_rcpf(den.y);
                    const f32x2 r = ex * rc, ig = ea * rc;
                    const f32x2 z = r * lc.z;
                    f32x2 av = z * (1.f / 24.f) + (-1.f / 6.f); av = av * z + 0.5f; av = av * z + (-1.f); av = av * z + 1.f;
                    const f32x2 om = 1.f - av * av;
                    f32x2 mu; mu.x = __builtin_amdgcn_sqrtf(__builtin_fabsf(om.x)); mu.y = __builtin_amdgcn_sqrtf(__builtin_fabsf(om.y));
                    const f32x2 xv = {xcv[n], xcv[n + 1]}; const f32x2 bb = mu * ig * xv;
                    Av[n] = av.x; Av[n + 1] = av.y; Bv[n] = bb.x; Bv[n + 1] = bb.y; }
            float P = 1.f, H = 0.f;
#pragma unroll
            for (int n = 0; n < NTOK; ++n) { const int nn = dir == 0 ? n : NTOK - 1 - n; H = Av[nn] * H + Bv[nn]; P *= Av[nn]; if constexpr (BLOB) { Bv[nn] = H; Av[nn] = P; } }
            float Pj[4], Hj[4];
#pragma unroll
            for (int j = 0; j < 4; ++j) { Pj[j] = __shfl(P, i16 + 16 * j); Hj[j] = __shfl(H, i16 + 16 * j); }
            {
                float Pt = 1.f, Ht = 0.f;
#pragma unroll
                for (int j = 0; j < 4; ++j) { const int jj = dir == 0 ? j : 3 - j; Ht = Pj[jj] * Ht + Hj[jj]; Pt *= Pj[jj]; }
                if (g == 0) *(f32x2*)(SUM + sum_index(b, sumchunk, dir, ch)) = (f32x2){Pt, Ht};
            }
            if constexpr (BLOB) {
                float Pe = 1.f, He = 0.f;
#pragma unroll
                for (int j = 0; j < 4; ++j) { const int jj = dir == 0 ? j : 3 - j; const bool before = dir == 0 ? (jj < g) : (jj > g); if (before) { He = Pj[jj] * He + Hj[jj]; Pe *= Pj[jj]; } }
#pragma unroll
                for (int n = 0; n < NTOK; ++n) { const float hl = Bv[n] + Av[n] * He, pl = Av[n] * Pe;
                    if (dir == 0) { hf[n] = hl; pfv[n] = pl; } else { hf[n] += hl; pbv[n] = pl; } }
            }
        }
        if constexpr (BLOB) {
            unsigned char* bp = blob + (size_t)(ct * 3) * 2048 + lane * 32;
#define LRU_ST(arr_, src_) do { _Pragma("unroll") for (int q = 0; q < 2; ++q) { v4u w; w.x = pk2(src_[8 * q], src_[8 * q + 1]); w.y = pk2(src_[8 * q + 2], src_[8 * q + 3]); w.z = pk2(src_[8 * q + 4], src_[8 * q + 5]); w.w = pk2(src_[8 * q + 6], src_[8 * q + 7]); \
                *(GAS v4u*)(bp + (arr_) * 2048 + q * 16) = w; } } while (0)
            LRU_ST(0, hf); LRU_ST(1, pfv); LRU_ST(2, pbv);
#undef LRU_ST
        }
    }
#undef LRU_LOADB
}

constexpr size_t LRU_BLOB_UNIT = 4 * 3 * 2048;
__device__ __forceinline__ void lru_apply_unit(Frame& F, int seqbase, int pos0, int h, const unsigned char* blob, float CinF, float CinB) {
    const int lane = F.lane, i16 = lane & 15, g = lane >> 4;
    const bf16* GY = (const bf16*)(F.ws + WS_GY); bf16* R = (bf16*)(F.ws + WS_R);
    LAS unsigned char* xt = F.lds + F.wave * LRU_WAVE_BYTES; LAS unsigned char* gt = xt + 64 * LRU_STRIDE;
    v4u bl[4][3][2];
#pragma unroll
    for (int ct = 0; ct < 4; ++ct)
#pragma unroll
        for (int arr = 0; arr < 3; ++arr)
#pragma unroll
            for (int q = 0; q < 2; ++q) bl[ct][arr][q] = *(const GAS v4u*)(blob + (size_t)(ct * 3 + arr) * 2048 + lane * 32 + q * 16);
    { const int p = pos0 + lane;
#pragma unroll
      for (int cc = 0; cc < 8; ++cc) *(LAS v4u*)(gt + lane * LRU_STRIDE + 16 * cc) = *(const GAS v4u*)(GY + (size_t)(seqbase + p) * 512 + h * 64 + 8 * cc); }
    LDS_WAIT(); asm volatile("" ::: "memory");
    const int tokD = 16 * g;
#pragma unroll
    for (int ct = 0; ct < 4; ++ct) {
        const float cf = __shfl(CinF, 16 * ct + i16), cb = __shfl(CinB, 16 * ct + i16);
#pragma unroll
        for (int q = 0; q < 2; ++q) { const unsigned sw[4] = {bl[ct][0][q].x, bl[ct][0][q].y, bl[ct][0][q].z, bl[ct][0][q].w}, fw[4] = {bl[ct][1][q].x, bl[ct][1][q].y, bl[ct][1][q].z, bl[ct][1][q].w}, bw[4] = {bl[ct][2][q].x, bl[ct][2][q].y, bl[ct][2][q].z, bl[ct][2][q].w};
#pragma unroll
            for (int e = 0; e < 4; ++e)
#pragma unroll
                for (int hh = 0; hh < 2; ++hh) { const int n = 8 * q + 2 * e + hh;
                    const float sv = hh ? __builtin_bit_cast(float, sw[e] & 0xffff0000u) : bf2f(sw[e] & 0xffffu), pf = hh ? __builtin_bit_cast(float, fw[e] & 0xffff0000u) : bf2f(fw[e] & 0xffffu), pb = hh ? __builtin_bit_cast(float, bw[e] & 0xffff0000u) : bf2f(bw[e] & 0xffffu);
                    const float gy = bf2f((unsigned)*(const LAS unsigned short*)(gt + (tokD + n) * LRU_STRIDE + (16 * ct + i16) * 2));
                    *(LAS unsigned short*)(xt + (tokD + n) * LRU_STRIDE + (16 * ct + i16) * 2) = (unsigned short)f2bf((sv + pf * cf + pb * cb) * gy); } }
    }
    LDS_WAIT(); asm volatile("" ::: "memory");
    { const int p = pos0 + lane;
#pragma unroll
      for (int cc = 0; cc < 8; ++cc) *(GAS v4u*)(R + (size_t)(seqbase + p) * 512 + h * 64 + 8 * cc) = *(const LAS v4u*)(xt + lane * LRU_STRIDE + 16 * cc); }
    LDS_WAIT(); asm volatile("" ::: "memory");
}
#ifndef PROBE_LO
#define PROBE_LO 0
#define PROBE_HI 0
#endif
#ifndef PROBE_BEFORE
#define PROBE_BEFORE 0
#endif
#ifndef PROBE_PAD
#define PROBE_PAD 3
#endif
__device__ __forceinline__ void ph2(Frame& F, const Args& args) {
    ProjSched S{(const char*)(F.ws + WS_HX), (const char*)(F.ws + WS_WIN), F.G, (int)blockIdx.x};
    EpiProj E{F.ws};
    pg8::gemm_phase<EpiProj, ProjSched, true, true, false>(F.lds, 1024, S, E);
}
__device__ __forceinline__ void ph3(Frame& F, const Args& args) {
    const int gw = F.vcu * NWAVES + F.wave, NGW = F.G * NWAVES;
    STAMP(F, 30);
    if (args.pad & 1) { fourierA_tables(F);
    for (int uid = gw; uid < 2048; uid += NGW) fourierA_unit(F, uid >> 7, (uid >> 2) & 31, uid & 3);
    __syncthreads(); }
    STAMP(F, 31);
    if (args.pad & 2) {
    LAS float* scr = (LAS float*)(F.lds + F.wave * LRU_WAVE_BYTES);
    constexpr int TR_REST = T_ALL - T_P0;
    int nu = 0;
    for (int uid = gw; uid < 4096; uid += NGW, ++nu) { const int h = uid & 7, j = (uid >> 3) & 31, b = uid >> 8;
        const int lo_ = (TR_REST / 2) * nu, hi_ = nu == 0 ? TR_REST / 2 : TR_REST;
        if (F.wave >= 4) tr_run(args, F.ws, T_P0 + lo_ + gw, NGW, T_P0 + hi_, F.lane, scr);
        lru_unit<4, 1, true>(F, args, b, b * SEQ, SEQ, 64 * j, h, 16 + j, (unsigned char*)args.out + (size_t)uid * LRU_BLOB_UNIT);
        if (F.wave < 4) tr_run(args, F.ws, T_P0 + lo_ + gw, NGW, T_P0 + hi_, F.lane, scr); }
    STAMP(F, 32);
    for (int uid = gw; uid < 2048; uid += NGW) { const int h = uid & 7, j = (uid >> 3) & 15, b = uid >> 7; lru_unit<1, 1, false>(F, args, b, NT + b * CTX, CTX, 16 * j, h, j, nullptr); } }
    STAMP(F, 33);
}
__device__ __forceinline__ void ph4(Frame& F, const Args& args) {
    const int gw = F.vcu * NWAVES + F.wave, NGW = F.G * NWAVES;
    STAMP(F, 40);
    float cF[2] = {0.f, 0.f}, cB[2] = {0.f, 0.f};
    if (args.pad & 2) {
#pragma unroll
    for (int k = 0; k < 2; ++k) { const int uid = gw + k * NGW; if (uid < 4096) lru_carry((const float*)(F.ws + WS_LRUSUM), uid >> 8, 16 + ((uid >> 3) & 31), (uid & 7) * 64 + F.lane, cF[k], cB[k]); } }
    STAMP(F, 41);
    if (args.pad & 1) { bf16x8 TW[2][2]; fourierB_twiddles(F.lane, TW);
      for (int uid = gw; uid < 4096; uid += NGW) fourierB_unit(F, uid >> 8, (uid >> 6) & 3, uid & 63, TW); }
    __syncthreads();
    STAMP(F, 42);
    if (args.pad & 2) {
#pragma unroll
    for (int k = 0; k < 2; ++k) { const int uid = gw + k * NGW; if (uid < 4096) { const int h = uid & 7, j = (uid >> 3) & 31, b = uid >> 8; lru_apply_unit(F, b * SEQ, 64 * j, h, (const unsigned char*)args.out + (size_t)uid * LRU_BLOB_UNIT, cF[k], cB[k]); } } }
    STAMP(F, 43);
}
__device__ __forceinline__ void ph5(Frame& F, const Args& args) {
    PairSched S{(const char*)(F.ws + WS_UF), (const char*)(F.ws + WS_WFO), (const char*)(F.ws + WS_R), (const char*)(F.ws + WS_WLO), F.G, (int)blockIdx.x};
    EpiMerge E{(const bf16*)(F.ws + WS_GF), (const bf16*)(F.ws + WS_GR), (bf16*)(F.ws + WS_HX)};
    pg8::gemm_phase<EpiMerge, PairSched, true, true, false>(F.lds, 512, S, E);
}
__device__ __forceinline__ void ph7(Frame& F, const Args& args) {
    PlainSched S{(const char*)(F.ws + WS_HX), (const char*)(F.ws + WS_WOUT), 128, 4, 1024, F.G, (int)blockIdx.x};
    EpiOut E{args.in[0], (const float*)(F.ws + WS_MOD), args.out};
    pg8::gemm_phase<EpiOut, PlainSched, true, true, false>(F.lds, 1024, S, E);
}
__device__ __forceinline__ void ph9(Frame& F, const Args& args) {
    moe_tables(F);
    MoeSched<true> S{F.MISC + 64, (const unsigned*)(F.ctl + CW_CNT), (const char*)(F.ws + WS_T), (const int*)(F.ws + WS_LISTS), nullptr, (const char*)(F.ws + WS_WGU), F.G, (int)blockIdx.x};
    EpiMoe1 E{(bf16*)(F.ws + WS_H)};
    pg8::gemm_phase<EpiMoe1, MoeSched<true>, true, true, true>(F.lds, 1024, S, E);
}
__device__ __forceinline__ void ph10(Frame& F, const Args& args) {
    moe_tables(F);
    MoeSched<false> S{F.MISC + 64, (const unsigned*)(F.ctl + CW_CNT), nullptr, nullptr, (const char*)(F.ws + WS_H), (const char*)(F.ws + WS_WD), F.G, (int)blockIdx.x};
    EpiY E{(bf16*)(F.ws + WS_Y)};
    pg8::gemm_phase<EpiY, MoeSched<false>, true, true, false>(F.lds, 512, S, E);
}
#ifndef PROBE_K
#define PROBE_K 4
#endif
#ifndef PROBE_REP
#define PROBE_REP -1
#endif
__global__ void __launch_bounds__(NWAVES * 64, 2) mk_fwd(Args args) {
    extern __shared__ __attribute__((aligned(16))) unsigned char lds[];
    Frame F;
    F.lds = (LAS unsigned char*)lds; F.MISC = (volatile LAS unsigned*)(F.lds + MISC_OFF);
    F.tid = threadIdx.x; F.lane = F.tid & 63; F.wave = __builtin_amdgcn_readfirstlane(F.tid >> 6);
    F.G = gridDim.x; { const int bx = blockIdx.x; F.vcu = (F.G % 8 == 0) ? (bx % 8) * (F.G / 8) + bx / 8 : bx; }
    F.ws = args.ws; F.ctl = (gu32*)(args.ws + WS_CTL);
    if (F.tid < 64) F.MISC[F.tid] = 0u;
    __syncthreads();
    XcdBarrier bar; bar.bar = (unsigned*)(F.ctl + CW_BAR); bar.x = 0; bar.st = nullptr;
    if (args.use_bar) bar = xcd_barrier_post((unsigned*)(F.ctl + CW_BAR), F.MISC + 8);
    F.tp0 = 0; F.tp1 = 0;
    const int lo = args.ph_lo, hi = args.ph_hi;
#define IN(k) (lo <= (k) && (k) < hi)
#define SEAM(k) do { if (IN(k) && IN((k) + 1)) xcd_barrier(bar); } while (0)
#ifndef PROBE_MASK
#define PROBE_MASK 3
#endif
#define PHASE(k, call) do { STAMP(F, k); if (IN(k)) { call; if (PROBE_REP == (k)) { xcd_barrier(bar); Args a2 = args; a2.pad = PROBE_MASK; { const Args& args = a2; call; } } } SEAM(k); } while (0)
    PHASE(0, p0_prologue(F, args));
    PHASE(1, p1_normmod(F, args));
    if (PROBE_REP == 100) { for (int q = 0; q < 10; ++q) xcd_barrier(bar); }
    PHASE(2, ph2(F, args));
    PHASE(3, ph3(F, args));
    PHASE(4, ph4(F, args));
    PHASE(5, ph5(F, args));
    PHASE(7, ph7(F, args));
    PHASE(8, p8_route(F, args));
    PHASE(9, ph9(F, args));
    PHASE(10, ph10(F, args));
    STAMP(F, 11);
    if (IN(11)) { moe_tables(F); if (PROBE_REP == 11) { p_final(F, args, (float*)(F.ws + WS_HX)); xcd_barrier(bar); } p_final(F, args, args.out); }
    STAMP(F, 12);
    if (PROBE_A >= 0) { if (blockIdx.x == 0 && F.tid == 0 && F.tp1 > F.tp0) { const unsigned long long d = (F.tp1 - F.tp0) * PROBE_K, t0 = __builtin_amdgcn_s_memrealtime(); while (__builtin_amdgcn_s_memrealtime() - t0 < d) __builtin_amdgcn_s_sleep(8); } }
#undef IN
#undef SEAM
#undef PHASE
}

extern "C" void kernel_launch(void* const* d_in, const int* in_sizes, int n_in, void* d_out, int out_size, void* d_ws, size_t ws_size, hipStream_t stream) {
    static int grid = 0;
    if (grid == 0) {
        if (n_in != 27 || ws_size < WS_END || out_size != NT * D) { fprintf(stderr, "kernel_launch: unexpected sizes n_in %d ws %zu out %d\n", n_in, ws_size, out_size); grid = -1; return; }
        int dev = 0, cus = 0;
        if (hipGetDevice(&dev) != hipSuccess || hipDeviceGetAttribute(&cus, hipDeviceAttributeMultiprocessorCount, dev) != hipSuccess) { grid = -1; return; }
        if (hipFuncSetAttribute((const void*)mk_fwd, hipFuncAttributeMaxDynamicSharedMemorySize, LDS_BYTES) != hipSuccess) { fprintf(stderr, "kernel_launch: hipFuncSetAttribute failed\n"); grid = -1; return; }
        int per_cu = 0;
        if (hipOccupancyMaxActiveBlocksPerMultiprocessor(&per_cu, (const void*)mk_fwd, NWAVES * 64, LDS_BYTES) != hipSuccess || per_cu < 1) { fprintf(stderr, "kernel_launch: occupancy query says %d\n", per_cu); }
        (void)hipGetLastError();
        grid = cus;
    }
    if (grid < 0) return;
    (void)hipMemsetAsync((char*)d_ws + WS_CTL, 0, CTL_ZERO_BYTES, stream);
    Args a{};
    for (int i = 0; i < 27; ++i) a.in[i] = (const float*)d_in[i];
    a.out = (float*)d_out; a.ws = (unsigned char*)d_ws; a.pad = 3;
#if PROBE_BEFORE
    a.use_bar = 0; a.pad = 0; a.ph_lo = 3; a.ph_hi = 4; hipLaunchKernelGGL(mk_fwd, dim3(grid), dim3(NWAVES * 64), LDS_BYTES, stream, a); a.pad = 3;
#endif
    a.use_bar = 1; a.ph_lo = 0; a.ph_hi = 12;
    hipLaunchKernelGGL(mk_fwd, dim3(grid), dim3(NWAVES * 64), LDS_BYTES, stream, a);
#if PROBE_HI > PROBE_LO
    a.use_bar = 0; a.out = (float*)((char*)d_ws + 124 * MiB); a.pad = PROBE_PAD;
    for (int ph = PROBE_LO; ph < PROBE_HI; ++ph) { a.ph_lo = ph; a.ph_hi = ph + 1; hipLaunchKernelGGL(mk_fwd, dim3(grid), dim3(NWAVES * 64), LDS_BYTES, stream, a); }
#endif
}
```
